# Optimizing an MI355X kernel written in HIP

```python
import math
import jax, jax.numpy as jnp
from jax import lax
import numpy as np

D_MODEL = 1024
BATCH = 16
SEQ = 2048
DEPTH = 2
DEC_BATCH = 8
DEC_SEQ = 16
PAST_LEN = 1024

CHUNK = 64
Q_BLOCK = 128
N_EVEN = (DEPTH + 1) // 2
N_ODD = DEPTH // 2
EPS = 1e-5
ROPE_THETA = 10000.0
N_MOD = 9
D_FF = ((8 * D_MODEL // 3 + 127) // 128) * 128
A_HEAD_DIM = 64
A_HEADS = D_MODEL // (4 * A_HEAD_DIM)
A_V_DIM = 2 * A_HEAD_DIM
A_SCALE = A_HEAD_DIM ** -0.5
MLA_HEADS = D_MODEL // 256
MLA_NOPE = 128
MLA_ROPE = 64
MLA_V = 128
MLA_Q_RANK = 3 * D_MODEL // 8
MLA_KV_RANK = D_MODEL // 4
MLA_SCALE = (MLA_NOPE + MLA_ROPE) ** -0.5
AB_IN = 2 * A_HEADS * 2 * A_HEAD_DIM + A_HEADS * A_V_DIM + MLA_Q_RANK + MLA_KV_RANK + MLA_ROPE
AB_OUT = A_HEADS * A_V_DIM + MLA_HEADS * MLA_V
C_HEAD_DIM = 64
C_HEADS = D_MODEL // C_HEAD_DIM
C_SCALE = C_HEAD_DIM ** -0.5
C_PAST_CHUNKS = 8
C_BAND_PAST = C_PAST_CHUNKS * CHUNK
C_BAND = C_BAND_PAST + CHUNK
REL_CLIP = 128

kernel_name = 'hybrid_streaming_encoder_step'


def _rmsnorm(x, g):
    xf = x.astype(jnp.float32)
    y = xf * lax.rsqrt(jnp.mean(xf * xf, axis=-1, keepdims=True) + EPS) * g.astype(jnp.float32)
    return y.astype(x.dtype)


def _modulate(x, g, shift, scale):
    return _rmsnorm(x, g) * (1 + scale[:, None, :]) + shift[:, None, :]


def _swiglu(h, w_in, w_out):
    gate, up = jnp.split(h @ w_in, 2, axis=-1)
    return (jax.nn.silu(gate) * up) @ w_out


def _rope(x, pos):
    d = x.shape[-1]
    half = d // 2
    inv = 1.0 / (ROPE_THETA ** (jnp.arange(half, dtype=jnp.float32) * (2.0 / d)))
    ang = pos.astype(jnp.float32)[:, None] * inv[None, :]
    shape = (1, pos.shape[0]) + (1,) * (x.ndim - 3) + (half,)
    cos = jnp.cos(ang).reshape(shape).astype(x.dtype)
    sin = jnp.sin(ang).reshape(shape).astype(x.dtype)
    x1, x2 = x[..., :half], x[..., half:]
    return jnp.concatenate([x1 * cos - x2 * sin, x2 * cos + x1 * sin], axis=-1)


def _sweep_query_blocks(fn, q_pos, *qs):
    L = q_pos.shape[0]
    qb = min(Q_BLOCK, L)
    nb = L // qb
    def split(a):
        return jnp.swapaxes(a.reshape((a.shape[0], nb, qb) + a.shape[2:]), 0, 1)
    outs = lax.map(fn, (q_pos.reshape(nb, qb),) + tuple(split(a) for a in qs))
    def merge(o):
        return jnp.swapaxes(o, 0, 1).reshape((o.shape[1], L) + o.shape[3:])
    return jax.tree_util.tree_map(merge, outs)


def _ab_mixer(h, pos0, past, lam_init, w_in, a_lambda, a_subln_g, q_norm_g, w_uq,
              kv_norm_g, w_ukv, w_out):
    bsz, L, _ = h.shape
    q_pos = pos0 + jnp.arange(L, dtype=jnp.int32)
    a_qk = A_HEADS * 2 * A_HEAD_DIM
    cuts = np.cumsum([a_qk, a_qk, A_HEADS * A_V_DIM, MLA_Q_RANK, MLA_KV_RANK]).tolist()
    aq, ak, av, cq, ckv, kr = jnp.split(h @ w_in, cuts, axis=-1)
    aq = _rope(aq.reshape(bsz, L, A_HEADS, 2, A_HEAD_DIM), q_pos)
    ak = _rope(ak.reshape(bsz, L, A_HEADS, 2, A_HEAD_DIM), q_pos)
    av = av.reshape(bsz, L, A_HEADS, A_V_DIM)
    bq = (_rmsnorm(cq, q_norm_g) @ w_uq).reshape(bsz, L, MLA_HEADS, MLA_NOPE + MLA_ROPE)
    bq_nope = bq[..., :MLA_NOPE]
    bq_rope = _rope(bq[..., MLA_NOPE:], q_pos)
    lat = _rmsnorm(ckv, kv_norm_g)
    kr = _rope(kr, q_pos)
    new_rows = (ak, av, lat, kr)
    if past is not None:
        ak, av, lat, kr = (jnp.concatenate([p_, n_], axis=1) for p_, n_ in zip(past, new_rows))
    Lk = ak.shape[1]
    k_pos = jnp.arange(Lk, dtype=jnp.int32)
    kv = (lat @ w_ukv).reshape(bsz, Lk, MLA_HEADS, MLA_NOPE + MLA_V)
    bk_nope, bv = kv[..., :MLA_NOPE], kv[..., MLA_NOPE:]
    lf = a_lambda.astype(jnp.float32)
    lam = jnp.exp(jnp.sum(lf[0] * lf[1])) - jnp.exp(jnp.sum(lf[2] * lf[3])) + lam_init

    def attend_block(args):
        qp, q_a, q_bn, q_br = args
        visible = (k_pos[None, :] // CHUNK) <= (qp[:, None] // CHUNK)
        s_a = jnp.einsum('bqhtd,bkhtd->bhtqk', q_a, ak).astype(jnp.float32) * A_SCALE
        p_a = jax.nn.softmax(jnp.where(visible, s_a, -jnp.inf), axis=-1)
        w_a = (p_a[:, :, 0] - lam * p_a[:, :, 1]).astype(av.dtype)
        o_a = jnp.einsum('bhqk,bkhe->bqhe', w_a, av)
        s_b = (jnp.einsum('bqhd,bkhd->bhqk', q_bn, bk_nope)
               + jnp.einsum('bqhr,bkr->bhqk', q_br, kr)).astype(jnp.float32) * MLA_SCALE
        p_b = jax.nn.softmax(jnp.where(visible, s_b, -jnp.inf), axis=-1).astype(bv.dtype)
        o_b = jnp.einsum('bhqk,bkhe->bqhe', p_b, bv)
        return (o_a, o_b)

    o_a, o_b = _sweep_query_blocks(attend_block, q_pos, aq, bq_nope, bq_rope)
    o_a = _rmsnorm(o_a, a_subln_g) * (1.0 - lam_init)
    out = jnp.concatenate([o_a.reshape(bsz, L, -1), o_b.reshape(bsz, L, -1)], axis=-1) @ w_out
    return out, new_rows


def _band_attend(q, k, v, q_pos, k_pos, rel_bias):
    qc = q_pos[:, None] // CHUNK
    kc = k_pos[None, :] // CHUNK
    valid = (kc <= qc) & (kc >= qc - C_PAST_CHUNKS) & (k_pos[None, :] >= 0)
    rel = jnp.clip(k_pos[None, :] - q_pos[:, None], -REL_CLIP, REL_CLIP) + REL_CLIP
    bias = rel_bias[:, rel].astype(jnp.float32)
    s = jnp.einsum('bqhd,bkhd->bhqk', q, k).astype(jnp.float32) * C_SCALE + bias
    p = jax.nn.softmax(jnp.where(valid, s, -jnp.inf), axis=-1).astype(v.dtype)
    return jnp.einsum('bhqk,bkhd->bqhd', p, v)


def _c_mixer(h, pos0, past, w_in, rel_bias, w_out):
    bsz, L, _ = h.shape
    q, k, v = (t.reshape(bsz, L, C_HEADS, C_HEAD_DIM) for t in jnp.split(h @ w_in, 3, axis=-1))
    q_pos = pos0 + jnp.arange(L, dtype=jnp.int32)
    if past is None:
        pad = ((0, 0), (C_BAND_PAST, 0), (0, 0), (0, 0))
        k_pad, v_pad = jnp.pad(k, pad), jnp.pad(v, pad)
        n_chunks = L // CHUNK
        q_chunks = jnp.swapaxes(q.reshape(bsz, n_chunks, CHUNK, C_HEADS, C_HEAD_DIM), 0, 1)

        def chunk_step(args):
            ci, q_c = args
            start = ci * CHUNK
            kb = lax.dynamic_slice_in_dim(k_pad, start, C_BAND, axis=1)
            vb = lax.dynamic_slice_in_dim(v_pad, start, C_BAND, axis=1)
            qp = start + jnp.arange(CHUNK, dtype=jnp.int32)
            kp = start - C_BAND_PAST + jnp.arange(C_BAND, dtype=jnp.int32)
            return _band_attend(q_c, kb, vb, qp, kp, rel_bias)

        o = lax.map(chunk_step, (jnp.arange(n_chunks, dtype=jnp.int32), q_chunks))
        o = jnp.swapaxes(o, 0, 1).reshape(bsz, L, C_HEADS * C_HEAD_DIM)
        keep = min(C_BAND_PAST, L)
        new_state = (k[:, L - keep:], v[:, L - keep:])
    else:
        pk, pv = past
        lc = pk.shape[1]
        k_all = jnp.concatenate([pk, k], axis=1)
        v_all = jnp.concatenate([pv, v], axis=1)
        k_pos = jnp.concatenate([pos0 - lc + jnp.arange(lc, dtype=jnp.int32), q_pos])
        o = _band_attend(q, k_all, v_all, q_pos, k_pos, rel_bias).reshape(bsz, L, C_HEADS * C_HEAD_DIM)
        new_state = (k_all[:, -lc:], v_all[:, -lc:])
    return o @ w_out, new_state


def _trunk(x, c, past, prm):
    pos0 = 0 if past is None else past['a_k'].shape[2]
    ab_rows, c_rows = [], []
    sc = jax.nn.silu(c)
    for l in range(DEPTH):
        mod = (sc @ prm['ada_w'][l] + prm['ada_b'][l]).reshape(c.shape[0], N_MOD, D_MODEL)
        g = prm['norm_g'][l]
        x = x + 0.5 * mod[:, 2][:, None] * _swiglu(_modulate(x, g[0], mod[:, 0], mod[:, 1]),
                                                    prm['ffn_w_in'][l, 0], prm['ffn_w_out'][l, 0])
        h = _modulate(x, g[1], mod[:, 3], mod[:, 4])
        if l % 2 == 0:
            i = l // 2
            lp = None if past is None else (past['a_k'][i], past['a_v'][i],
                                            past['mla_latent'][i], past['mla_krope'][i])
            mix, rows = _ab_mixer(h, pos0, lp, 0.8 - 0.6 * math.exp(-0.3 * l),
                                  prm['ab_w_in'][i], prm['a_lambda'][i], prm['a_subln_g'][i],
                                  prm['mla_q_norm_g'][i], prm['mla_w_uq'][i],
                                  prm['mla_kv_norm_g'][i], prm['mla_w_ukv'][i], prm['ab_w_out'][i])
            ab_rows.append(rows)
        else:
            i = l // 2
            lp = None if past is None else (past['c_k'][i], past['c_v'][i])
            mix, rows = _c_mixer(h, pos0, lp, prm['c_w_in'][i], prm['c_rel_bias'][i], prm['c_w_out'][i])
            c_rows.append(rows)
        x = x + mod[:, 5][:, None] * mix
        x = x + 0.5 * mod[:, 8][:, None] * _swiglu(_modulate(x, g[2], mod[:, 6], mod[:, 7]),
                                                    prm['ffn_w_in'][l, 1], prm['ffn_w_out'][l, 1])
    y = _rmsnorm(x, prm['final_norm_g'])
    ab_state = tuple(jnp.stack([r[j] for r in ab_rows]) for j in range(4))
    c_state = tuple(jnp.stack([r[j] for r in c_rows]) for j in range(2))
    return y, ab_state, c_state


def setup_inputs(seed: int = 0) -> dict:
    key = jax.random.key(seed)
    k = jax.random.split(key, 27)
    f32 = jnp.float32
    def nrm(kk, shape, scale):
        return jax.random.normal(kk, shape, f32) * scale
    def gain(kk, shape):
        return 1.0 + 0.02 * jax.random.normal(kk, shape, f32)
    c_len = min(C_BAND_PAST, PAST_LEN)
    return {
        'x_prompt': nrm(k[0], (BATCH, SEQ, D_MODEL), 1.0),
        'x_sample': nrm(k[1], (DEC_BATCH, DEC_SEQ, D_MODEL), 1.0),
        'cache_a_k': nrm(k[2], (N_EVEN, DEC_BATCH, PAST_LEN, A_HEADS, 2, A_HEAD_DIM), 1.0),
        'cache_a_v': nrm(k[3], (N_EVEN, DEC_BATCH, PAST_LEN, A_HEADS, A_V_DIM), 1.0),
        'cache_mla_latent': nrm(k[4], (N_EVEN, DEC_BATCH, PAST_LEN, MLA_KV_RANK), 1.0),
        'cache_mla_krope': nrm(k[5], (N_EVEN, DEC_BATCH, PAST_LEN, MLA_ROPE), 1.0),
        'cache_c_k': nrm(k[6], (N_ODD, DEC_BATCH, c_len, C_HEADS, C_HEAD_DIM), 1.0),
        'cache_c_v': nrm(k[7], (N_ODD, DEC_BATCH, c_len, C_HEADS, C_HEAD_DIM), 1.0),
        'c_prompt': nrm(k[8], (BATCH, D_MODEL), 1.0),
        'c_sample': nrm(k[9], (DEC_BATCH, D_MODEL), 1.0),
        'ada_w': nrm(k[10], (DEPTH, D_MODEL, N_MOD * D_MODEL), 0.6 * D_MODEL ** -0.5),
        'ada_b': nrm(k[11], (DEPTH, N_MOD * D_MODEL), 0.02),
        'norm_g': gain(k[12], (DEPTH, 3, D_MODEL)),
        'ffn_w_in': nrm(k[13], (DEPTH, 2, D_MODEL, 2 * D_FF), D_MODEL ** -0.5),
        'ffn_w_out': nrm(k[14], (DEPTH, 2, D_FF, D_MODEL), D_FF ** -0.5),
        'ab_w_in': nrm(k[15], (N_EVEN, D_MODEL, AB_IN), D_MODEL ** -0.5),
        'a_lambda': nrm(k[16], (N_EVEN, 4, A_HEAD_DIM), 0.1),
        'a_subln_g': gain(k[17], (N_EVEN, A_V_DIM)),
        'mla_q_norm_g': gain(k[18], (N_EVEN, MLA_Q_RANK)),
        'mla_w_uq': nrm(k[19], (N_EVEN, MLA_Q_RANK, MLA_HEADS * (MLA_NOPE + MLA_ROPE)), MLA_Q_RANK ** -0.5),
        'mla_kv_norm_g': gain(k[20], (N_EVEN, MLA_KV_RANK)),
        'mla_w_ukv': nrm(k[21], (N_EVEN, MLA_KV_RANK, MLA_HEADS * (MLA_NOPE + MLA_V)), MLA_KV_RANK ** -0.5),
        'ab_w_out': nrm(k[22], (N_EVEN, AB_OUT, D_MODEL), AB_OUT ** -0.5),
        'c_w_in': nrm(k[23], (N_ODD, D_MODEL, 3 * C_HEADS * C_HEAD_DIM), D_MODEL ** -0.5),
        'c_rel_bias': nrm(k[24], (N_ODD, C_HEADS, 2 * REL_CLIP + 1), 0.2),
        'c_w_out': nrm(k[25], (N_ODD, C_HEADS * C_HEAD_DIM, D_MODEL), (C_HEADS * C_HEAD_DIM) ** -0.5),
        'final_norm_g': gain(k[26], (D_MODEL,)),
    }


def reference(x_prompt, x_sample, cache_a_k, cache_a_v, cache_mla_latent, cache_mla_krope,
              cache_c_k, cache_c_v, c_prompt, c_sample, ada_w, ada_b, norm_g, ffn_w_in, ffn_w_out,
              ab_w_in, a_lambda, a_subln_g, mla_q_norm_g, mla_w_uq, mla_kv_norm_g, mla_w_ukv,
              ab_w_out, c_w_in, c_rel_bias, c_w_out, final_norm_g):
    prm = dict(ada_w=ada_w, ada_b=ada_b, norm_g=norm_g, ffn_w_in=ffn_w_in, ffn_w_out=ffn_w_out,
               ab_w_in=ab_w_in, a_lambda=a_lambda, a_subln_g=a_subln_g, mla_q_norm_g=mla_q_norm_g,
               mla_w_uq=mla_w_uq, mla_kv_norm_g=mla_kv_norm_g, mla_w_ukv=mla_w_ukv,
               ab_w_out=ab_w_out, c_w_in=c_w_in, c_rel_bias=c_rel_bias, c_w_out=c_w_out,
               final_norm_g=final_norm_g)
    y_prompt, ab_p, c_p = _trunk(x_prompt, c_prompt, None, prm)
    past = dict(a_k=cache_a_k, a_v=cache_a_v, mla_latent=cache_mla_latent,
                mla_krope=cache_mla_krope, c_k=cache_c_k, c_v=cache_c_v)
    y_sample, ab_s, c_s = _trunk(x_sample, c_sample, past, prm)
    a_k_p, a_v_p, lat_p, kr_p = ab_p
    a_k_s, a_v_s, lat_s, kr_s = ab_s
    c_k_p, c_v_p = c_p
    c_k_s, c_v_s = c_s
    return (y_prompt, y_sample, a_k_p, a_k_s, a_v_p, a_v_s, lat_p, lat_s, kr_p, kr_s,
            c_k_p, c_k_s, c_v_p, c_v_s)
```

```cpp
#include <hip/hip_runtime.h>
#include <hip/hip_cooperative_groups.h>
#include <cstdio>
#include <cstdint>
namespace cg = cooperative_groups;

#define LAS __attribute__((address_space(3)))
typedef unsigned short bf16_t;
typedef short bf16x8 __attribute__((ext_vector_type(8)));
typedef short s16x4 __attribute__((ext_vector_type(4)));
typedef float f32x4 __attribute__((ext_vector_type(4)));
typedef float f32x2 __attribute__((ext_vector_type(2)));
typedef unsigned u32x4 __attribute__((ext_vector_type(4)));
typedef unsigned u32x2 __attribute__((ext_vector_type(2)));
typedef __bf16 bf16x2_t __attribute__((ext_vector_type(2)));

constexpr int DM = 1024, NP = 32768, NS = 128, MR = NP + NS, MT = 33024;
constexpr int DFF = 2816, NMOD = 9;
constexpr int LKS = 1040, LKSP = 1088;
constexpr int MKV = NP + 8 * LKSP;
constexpr int LCS = 528, LCSP = 576;
constexpr int PROJ_LD = 2304;
constexpr float EPS = 1e-5f;
constexpr float LOG2E = 1.4426950408889634f;
constexpr float LAM_INIT = 0.2f;

constexpr size_t O_Y = 0;
constexpr size_t O_AK = 33685504, O_AV = 50528256, O_LAT = 67371008, O_KR = 75792384;
constexpr size_t O_CKP = 77897728, O_CKS = 86286336, O_CVP = 90480640, O_CVS = 98869248, O_END = 103063552;

constexpr size_t al256(size_t x) { return (x + 255) & ~(size_t)255; }
constexpr size_t OFF_MOD = 0;
constexpr size_t OFF_WFI = al256(OFF_MOD + (size_t)2 * 24 * 9216 * 4);
constexpr size_t OFF_WFO = OFF_WFI + (size_t)4 * 5632 * 1024 * 2;
constexpr size_t OFF_WABI = OFF_WFO + (size_t)4 * 1024 * 2816 * 2;
constexpr size_t OFF_WUQ = OFF_WABI + (size_t)2304 * 1024 * 2;
constexpr size_t OFF_WUKV = OFF_WUQ + (size_t)768 * 384 * 2;
constexpr size_t OFF_WABO = OFF_WUKV + (size_t)1024 * 256 * 2;
constexpr size_t OFF_WCI = OFF_WABO + (size_t)1024 * 1024 * 2;
constexpr size_t OFF_WCO = OFF_WCI + (size_t)3072 * 1024 * 2;
constexpr size_t OFF_H = OFF_WCO + (size_t)1024 * 1024 * 2;
constexpr size_t OFF_BIG = OFF_H + (size_t)MT * 1024 * 2;
constexpr size_t OFF_BQ = OFF_BIG + (size_t)MT * PROJ_LD * 2;
constexpr size_t OFF_KV = OFF_BIG + (size_t)MT * 3072 * 2;
constexpr size_t OFF_LAT = OFF_KV + (size_t)MKV * 1024 * 2;
constexpr size_t OFF_KR = OFF_LAT + (size_t)MKV * 256 * 2;
constexpr size_t OFF_KAS = OFF_KR + (size_t)MKV * 64 * 2;
constexpr size_t OFF_VAS = OFF_KAS + (size_t)8 * LKSP * 512 * 2;
constexpr size_t OFF_KCS = OFF_VAS + (size_t)8 * LKSP * 512 * 2;
constexpr size_t OFF_VCS = OFF_KCS + (size_t)8 * LCSP * 1024 * 2;
constexpr size_t OFF_GS = OFF_VCS + (size_t)8 * LCSP * 1024 * 2;
constexpr size_t OFF_SHB = OFF_GS + (size_t)7 * 24 * 1024 * 4;
constexpr size_t OFF_BW = OFF_SHB + (size_t)6 * 128 * 1024 * 2;
constexpr size_t OFF_SSQ = OFF_BW + (size_t)24 * 27904 * 4;
constexpr size_t OFF_RGS = OFF_SSQ + (size_t)7 * 33024 * 4;
constexpr size_t OFF_BAR = OFF_RGS + (size_t)6 * 24 * 1024 * 4;
constexpr size_t WS_END = OFF_BAR + (size_t)3456 * 4;
static_assert(OFF_BQ + (size_t)MT * 768 * 2 <= OFF_KV, "BQ fits in BIG tail");
static_assert(WS_END <= (size_t)536870912, "workspace fits 512 MiB");

constexpr int LDS_BYTES = 135168;

struct Params { const float* in[27]; float* out; unsigned char* ws; };

__device__ __forceinline__ float bf2f(unsigned h) { return __uint_as_float(h << 16); }
__device__ __forceinline__ unsigned pk2(float lo, float hi) { f32x2 v = {lo, hi}; bf16x2_t b = __builtin_convertvector(v, bf16x2_t); return __builtin_bit_cast(unsigned, b); }
__device__ __forceinline__ float wave_sum(float v) {
#pragma unroll
    for (int o = 1; o < 64; o <<= 1) v += __shfl_xor(v, o);
    return v;
}
__device__ __forceinline__ int row_batch(int row) { return row < NP ? (row >> 11) : 16 + ((row - NP) >> 4); }
__device__ __forceinline__ int row_pos(int row) { return row < NP ? (row & 2047) : 1024 + ((row - NP) & 15); }
__device__ __forceinline__ float silu_f(float g) { return g * __builtin_amdgcn_rcpf(1.0f + __builtin_amdgcn_exp2f(-g * LOG2E)); }

__device__ __forceinline__ float rows_max(float v) {
    auto a = __builtin_amdgcn_permlane16_swap(__float_as_uint(v), __float_as_uint(v), false, false);
    v = fmaxf(__uint_as_float(a[0]), __uint_as_float(a[1]));
    auto b = __builtin_amdgcn_permlane32_swap(__float_as_uint(v), __float_as_uint(v), false, false);
    return fmaxf(__uint_as_float(b[0]), __uint_as_float(b[1]));
}
__device__ __forceinline__ float rows_sum(float v) {
    auto a = __builtin_amdgcn_permlane16_swap(__float_as_uint(v), __float_as_uint(v), false, false);
    v = __uint_as_float(a[0]) + __uint_as_float(a[1]);
    auto b = __builtin_amdgcn_permlane32_swap(__float_as_uint(v), __float_as_uint(v), false, false);
    return __uint_as_float(b[0]) + __uint_as_float(b[1]);
}

namespace pg8 {
constexpr int BM = 256, BK = 64, HALF = 128, HTB = HALF * BK * 2, STAGE_BYTES = 8 * HTB, NXCD = 8, WGM = 4;
__host__ __device__ __forceinline__ int lds_byte(int r, int c) { const int st = (r >> 4) * 2 + (c >> 5), rr = r & 15, cc = c & 31, ob = rr * 64 + cc * 2; return st * 1024 + (ob ^ (((ob >> 9) & 1) << 5)); }
__host__ __device__ __forceinline__ void stage_rc(int b, int& R, int& C) { const int st = b / 1024, sb = b % 1024, swz = sb ^ (((sb >> 9) & 1) << 5); R = (st >> 1) * 16 + swz / 64; C = (st & 1) * 32 + (swz % 64) / 2; }
__host__ __device__ __forceinline__ int perm32(int rho) { const int n = rho >> 4, i = rho & 15; return 8 * (i >> 2) + 4 * n + (i & 3); }
struct Unit { int pm, pn; };
struct Gemm { const bf16_t* A; const bf16_t* Bt; int M, N, K, lda; };
struct StaticOrder {
    int nM, nN, nwg, G, c;
    __device__ void init(int M, int N, int G_, int c_) { nM = M / BM; nN = N / BM; nwg = nM * nN; G = G_; c = c_; }
    __device__ bool next(int i, Unit& u) const {
        const long L = (long)i * G + c; if (L >= nwg) return false;
        int wgid = (int)L; { const int q = nwg / NXCD, r = nwg % NXCD, xcd = wgid % NXCD, off = wgid / NXCD; wgid = (xcd < r ? xcd * (q + 1) : r * (q + 1) + (xcd - r) * q) + off; }
        const int nig = WGM * nN, gid = wgid / nig, fm = gid * WGM, gsz = (nM - fm) < WGM ? (nM - fm) : WGM;
        u.pm = fm + ((wgid % nig) % gsz); u.pn = (wgid % nig) / gsz; return true;
    }
};

template <class Epi>
__device__ __forceinline__ void gemm_phase(LAS unsigned char* lds, const Gemm g, const StaticOrder& S, const Epi& E) {
    int tid_ = threadIdx.x; asm volatile("" : "+v"(tid_));
    const int tid = tid_, wid = __builtin_amdgcn_readfirstlane(tid >> 6), lane = tid & 63, wr = wid >> 2, wc = wid & 3, fr = lane & 15, fq = lane >> 4;
    const int K = g.K, nt = K / BK, lda = g.lda;
    unsigned voffA[2], voffB[2];
#pragma unroll
    for (int i = 0; i < 2; ++i) { int R, C; stage_rc(tid * 16 + i * 8192, R, C); const int Rb = Epi::PERM ? ((R & ~31) + perm32(R & 31)) : R;
        voffA[i] = (unsigned)(R * lda + C) * 2u; voffB[i] = (unsigned)(Rb * K + C) * 2u; }
    const size_t kstep = (size_t)(BK * 2);
    const size_t hstepA = (size_t)HALF * lda * 2, hstepB = (size_t)HALF * K * 2;
    const size_t tstepA = 2 * hstepA, tstepB = 2 * hstepB;
    const unsigned ldsw = (unsigned)wid * 1024u;
    const int aoff = lds_byte(wr * 64 + fr, fq * 8), boff = lds_byte(wc * 32 + fr, fq * 8);
#define PG8_SA(b, h) (((b) * 2 + (h)) * HTB)
#define PG8_SB(b, h) ((4 + (b) * 2 + (h)) * HTB)
#define PG8_STAGE(bufoff, gbase, voff) do { _Pragma("unroll") for (int _i = 0; _i < 2; ++_i) \
        __builtin_amdgcn_global_load_lds((const unsigned*)((const char*)(gbase) + (voff)[_i]), (LAS unsigned*)(lds + (bufoff) + ldsw + _i * 8192), 16, 0, 0); } while (0)
#define PG8_LDA(dst, b, h) do { _Pragma("unroll") for (int m = 0; m < 4; ++m) _Pragma("unroll") for (int k = 0; k < 2; ++k) dst[m][k] = *(const LAS bf16x8*)(lds + PG8_SA(b, h) + aoff + m * 2048 + k * 1024); } while (0)
#define PG8_LDB(dst, b, h) do { _Pragma("unroll") for (int n = 0; n < 2; ++n) _Pragma("unroll") for (int k = 0; k < 2; ++k) dst[n][k] = *(const LAS bf16x8*)(lds + PG8_SB(b, h) + boff + n * 2048 + k * 1024); } while (0)
#define PG8_MMA(ai, bj, At, Bt) do { __builtin_amdgcn_s_setprio(1); _Pragma("unroll") for (int m = 0; m < 4; ++m) _Pragma("unroll") for (int n = 0; n < 2; ++n) _Pragma("unroll") for (int k = 0; k < 2; ++k) \
        acc[ai][bj][m][n] = __builtin_amdgcn_mfma_f32_16x16x32_bf16(Bt[n][k], At[m][k], acc[ai][bj][m][n], 0, 0, 0); __builtin_amdgcn_s_setprio(0); } while (0)
#define PG8_WAIT_V(n) asm volatile("s_waitcnt vmcnt(" #n ")" ::: "memory")
#define PG8_WAIT_L(n) asm volatile("s_waitcnt lgkmcnt(" #n ")" ::: "memory")
#define PG8_BAR __builtin_amdgcn_s_barrier()
#define PG8_SCHED __builtin_amdgcn_sched_barrier(0)
    Unit cur, nxt; int ui = 0;
    if (!S.next(0, cur)) return;
    f32x4 acc[2][2][4][2];
#pragma unroll
    for (int a = 0; a < 2; ++a)
#pragma unroll
        for (int b = 0; b < 2; ++b)
#pragma unroll
            for (int m = 0; m < 4; ++m)
#pragma unroll
                for (int n = 0; n < 2; ++n) acc[a][b][m][n] = (f32x4){0.f, 0.f, 0.f, 0.f};
    bf16x8 At[4][2], B0[2][2], B1[2][2];
    const char* cA = (const char*)g.A + (size_t)cur.pm * tstepA; const char* cB = (const char*)g.Bt + (size_t)cur.pn * tstepB;
    PG8_STAGE(PG8_SB(0, 0), cB, voffB); PG8_STAGE(PG8_SB(0, 1), cB + hstepB, voffB); PG8_STAGE(PG8_SA(0, 0), cA, voffA); PG8_STAGE(PG8_SA(0, 1), cA + hstepA, voffA);
    if (wr == 1) PG8_BAR;
    PG8_WAIT_V(2); PG8_BAR;
    PG8_STAGE(PG8_SB(1, 0), cB + kstep, voffB); PG8_STAGE(PG8_SA(1, 0), cA + kstep, voffA); PG8_STAGE(PG8_SB(1, 1), cB + hstepB + kstep, voffB);
    PG8_WAIT_V(6); PG8_BAR;
    for (;;) {
        const bool has_next = S.next(ui + 1, nxt);
        const char* nA = has_next ? (const char*)g.A + (size_t)nxt.pm * tstepA : cA; const char* nB = has_next ? (const char*)g.Bt + (size_t)nxt.pn * tstepB : cB;
        for (int t = 0; t < nt; t += 2) {
            const bool last = (t == nt - 2);
            const char* a1 = cA + (size_t)(t + 1) * kstep;
            const char* a2 = last ? nA : cA + (size_t)(t + 2) * kstep; const char* b2 = last ? nB : cB + (size_t)(t + 2) * kstep;
            const char* a3 = a2 + kstep; const char* b3 = b2 + kstep;
            PG8_LDB(B0, 0, 0); PG8_LDB(B1, 0, 1); PG8_SCHED; PG8_LDA(At, 0, 0); PG8_STAGE(PG8_SA(1, 1), a1 + hstepA, voffA);
            PG8_WAIT_V(8); PG8_WAIT_L(0); PG8_BAR; PG8_MMA(0, 0, At, B0); PG8_MMA(0, 1, At, B1); PG8_BAR; PG8_SCHED;
            PG8_LDA(At, 0, 1); PG8_STAGE(PG8_SB(0, 0), b2, voffB); PG8_STAGE(PG8_SB(0, 1), b2 + hstepB, voffB); PG8_STAGE(PG8_SA(0, 0), a2, voffA);
            PG8_WAIT_V(8); PG8_WAIT_L(0); PG8_BAR; PG8_MMA(1, 0, At, B0); PG8_MMA(1, 1, At, B1); PG8_BAR; PG8_SCHED;
            PG8_LDB(B0, 1, 0); PG8_LDB(B1, 1, 1); PG8_SCHED; PG8_LDA(At, 1, 0); PG8_STAGE(PG8_SA(0, 1), a2 + hstepA, voffA);
            PG8_WAIT_V(8); PG8_WAIT_L(0); PG8_BAR; PG8_MMA(0, 0, At, B0); PG8_MMA(0, 1, At, B1); PG8_BAR; PG8_SCHED;
            PG8_LDA(At, 1, 1); PG8_STAGE(PG8_SB(1, 0), b3, voffB); PG8_STAGE(PG8_SB(1, 1), b3 + hstepB, voffB); PG8_STAGE(PG8_SA(1, 0), a3, voffA);
            PG8_WAIT_V(8); PG8_WAIT_L(0); PG8_BAR; PG8_MMA(1, 0, At, B0); PG8_MMA(1, 1, At, B1); PG8_BAR; PG8_SCHED;
        }
        if (wr == 0) PG8_BAR;
        E(acc, cur, wr, wc, fr, fq);
        if (!has_next) break;
#pragma unroll
        for (int a = 0; a < 2; ++a)
#pragma unroll
            for (int b = 0; b < 2; ++b)
#pragma unroll
                for (int m = 0; m < 4; ++m)
#pragma unroll
                    for (int n = 0; n < 2; ++n) acc[a][b][m][n] = (f32x4){0.f, 0.f, 0.f, 0.f};
        cur = nxt; cA = nA; cB = nB; ++ui;
        if (wr == 1) PG8_BAR;
    }
    PG8_WAIT_V(0);
    PG8_BAR;
#undef PG8_SA
#undef PG8_SB
#undef PG8_STAGE
#undef PG8_LDA
#undef PG8_LDB
#undef PG8_MMA
#undef PG8_WAIT_V
#undef PG8_WAIT_L
#undef PG8_BAR
#undef PG8_SCHED
}

template <bool HAS_AN, bool FROM_F32>
struct EpiResid {
    static constexpr bool PERM = false;
    const float* xp; float* X; const float* modp; float coef; float* ssq; const float* gs; const float* rgs; bf16_t* An;
    __device__ __forceinline__ void operator()(const f32x4 (&acc)[2][2][4][2], const Unit& u, int wr, int wc, int fr, int fq) const {
        const int b = (u.pm * BM) >> 11; const float cf_ = coef;
        const int colb = u.pn * BM + wc * 32 + fq * 4;
        f32x4 gvv[2][2], gsv[2][2], rgv[2][2];
#pragma unroll
        for (int bj = 0; bj < 2; ++bj)
#pragma unroll
            for (int n = 0; n < 2; ++n) { const f32x4 t_ = *(const f32x4*)(modp + (size_t)b * 9216 + colb + bj * HALF + n * 16); gvv[bj][n] = (f32x4){t_[0] * cf_, t_[1] * cf_, t_[2] * cf_, t_[3] * cf_};
                if (HAS_AN) gsv[bj][n] = *(const f32x4*)(gs + (size_t)b * 1024 + colb + bj * HALF + n * 16);
                if (!FROM_F32) rgv[bj][n] = *(const f32x4*)(rgs + (size_t)b * 1024 + colb + bj * HALF + n * 16); }
        const size_t rowoff = (size_t)(u.pm * BM + wr * 64 + fr) * DM + colb;
        const float* __restrict__ basep = xp + rowoff;
        float* __restrict__ outp = X + rowoff;
        bf16_t* anp = An + rowoff;
        float* ssqp = ssq + u.pm * BM + wr * 64 + fr;
#pragma unroll
        for (int ai = 0; ai < 2; ++ai) {
            f32x4 bsf[FROM_F32 ? 2 : 1][2][2]; u32x2 bsh[FROM_F32 ? 1 : 4][2][2];
            if (!FROM_F32) {
#pragma unroll
                for (int m = 0; m < 4; ++m)
#pragma unroll
                    for (int bj = 0; bj < 2; ++bj)
#pragma unroll
                        for (int n = 0; n < 2; ++n) bsh[m][bj][n] = *(const u32x2*)(anp + (size_t)(ai * HALF + m * 16) * DM + bj * HALF + n * 16);
            }
#pragma unroll
            for (int mp = 0; mp < 2; ++mp) {
                if (FROM_F32) {
#pragma unroll
                    for (int mm = 0; mm < 2; ++mm)
#pragma unroll
                        for (int bj = 0; bj < 2; ++bj)
#pragma unroll
                            for (int n = 0; n < 2; ++n) bsf[mm][bj][n] = *(const f32x4*)(basep + (size_t)(ai * HALF + (2 * mp + mm) * 16) * DM + bj * HALF + n * 16);
                }
#pragma unroll
                for (int mm = 0; mm < 2; ++mm) {
                    const int m = 2 * mp + mm; const size_t ro = (size_t)(ai * HALF + m * 16) * DM; float sq = 0.f;
#pragma unroll
                    for (int bj = 0; bj < 2; ++bj)
#pragma unroll
                        for (int n = 0; n < 2; ++n) {
                            f32x4 xo;
                            if (FROM_F32) xo = bsf[mm][bj][n];
                            else { const u32x2 r_ = bsh[m][bj][n]; xo = (f32x4){bf2f(r_.x & 0xffff), bf2f(r_.x >> 16), bf2f(r_.y & 0xffff), bf2f(r_.y >> 16)} * rgv[bj][n]; }
                            const f32x4 xn = xo + gvv[bj][n] * acc[ai][bj][m][n];
                            sq += xn[0] * xn[0] + xn[1] * xn[1] + xn[2] * xn[2] + xn[3] * xn[3];
                            if (HAS_AN) { const f32x4 hv = xn * gsv[bj][n]; u32x2 o; o.x = pk2(hv[0], hv[1]); o.y = pk2(hv[2], hv[3]); *(u32x2*)(anp + ro + bj * HALF + n * 16) = o; }
                            else *(f32x4*)(outp + ro + bj * HALF + n * 16) = xn; }
                    sq = rows_sum(sq);
                    if (fq == (m & 3)) __hip_atomic_fetch_add(ssqp + ai * HALF + m * 16, sq, __ATOMIC_RELAXED, __HIP_MEMORY_SCOPE_AGENT);
                }
            }
        }
    }
};
struct EpiSwiglu {
    static constexpr bool PERM = true;
    bf16_t* ACT; const float* ssq; const float* biasw;
    __device__ __forceinline__ void operator()(const f32x4 (&acc)[2][2][4][2], const Unit& u, int wr, int wc, int fr, int fq) const {
        const int b = (u.pm * BM) >> 11;
        const float* bw = biasw + (size_t)b * 5632 + u.pn * BM + wc * 32 + 8 * fq;
        const f32x4 bg0 = *(const f32x4*)(bw), bg1 = *(const f32x4*)(bw + 4), bu0 = *(const f32x4*)(bw + 128), bu1 = *(const f32x4*)(bw + 132);
        float rs[2][4];
#pragma unroll
        for (int ai = 0; ai < 2; ++ai)
#pragma unroll
            for (int m = 0; m < 4; ++m) rs[ai][m] = ssq[u.pm * BM + ai * HALF + wr * 64 + m * 16 + fr];
#pragma unroll
        for (int ai = 0; ai < 2; ++ai)
#pragma unroll
            for (int m = 0; m < 4; ++m) {
                const int row = u.pm * BM + ai * HALF + wr * 64 + m * 16 + fr;
                const float rstd = __builtin_amdgcn_rsqf(rs[ai][m] * (1.0f / 1024.0f) + EPS);
                bf16_t* p = ACT + (size_t)row * DFF + u.pn * 128 + wc * 32 + 8 * fq;
                const f32x4 g0 = acc[ai][0][m][0] * rstd + bg0, g1 = acc[ai][0][m][1] * rstd + bg1, u0 = acc[ai][1][m][0] * rstd + bu0, u1 = acc[ai][1][m][1] * rstd + bu1;
                u32x4 w;
                w.x = pk2(silu_f(g0[0]) * u0[0], silu_f(g0[1]) * u0[1]); w.y = pk2(silu_f(g0[2]) * u0[2], silu_f(g0[3]) * u0[3]);
                w.z = pk2(silu_f(g1[0]) * u1[0], silu_f(g1[1]) * u1[1]); w.w = pk2(silu_f(g1[2]) * u1[2], silu_f(g1[3]) * u1[3]);
                *(u32x4*)p = w;
            }
    }
};
template <bool NORM>
struct EpiBf16 {
    static constexpr bool PERM = true;
    bf16_t* O; int ldc; float scale; const float* ssq; const float* biasw; int ldb;
    __device__ __forceinline__ void operator()(const f32x4 (&acc)[2][2][4][2], const Unit& u, int wr, int wc, int fr, int fq) const {
        f32x4 bv[2][2];
        if (NORM) { const int b = (u.pm * BM) >> 11; const float* bw = biasw + (size_t)b * ldb + u.pn * BM + wc * 32 + 8 * fq;
#pragma unroll
            for (int bj = 0; bj < 2; ++bj) { bv[bj][0] = *(const f32x4*)(bw + bj * HALF); bv[bj][1] = *(const f32x4*)(bw + bj * HALF + 4); } }
        float rs[2][4];
        if (NORM) {
#pragma unroll
            for (int ai = 0; ai < 2; ++ai)
#pragma unroll
                for (int m = 0; m < 4; ++m) rs[ai][m] = ssq[u.pm * BM + ai * HALF + wr * 64 + m * 16 + fr];
        }
#pragma unroll
        for (int ai = 0; ai < 2; ++ai)
#pragma unroll
            for (int m = 0; m < 4; ++m) {
                const int row = u.pm * BM + ai * HALF + wr * 64 + m * 16 + fr;
                float rstd = 1.0f; if (NORM) rstd = __builtin_amdgcn_rsqf(rs[ai][m] * (1.0f / 1024.0f) + EPS);
                bf16_t* rowp = O + (size_t)row * ldc + u.pn * BM + wc * 32 + 8 * fq;
#pragma unroll
                for (int bj = 0; bj < 2; ++bj) { f32x4 v0 = acc[ai][bj][m][0], v1 = acc[ai][bj][m][1];
                    if (NORM) { v0 = v0 * rstd + bv[bj][0]; v1 = v1 * rstd + bv[bj][1]; }
                    v0 = v0 * scale; v1 = v1 * scale;
                    u32x4 w; w.x = pk2(v0[0], v0[1]); w.y = pk2(v0[2], v0[3]); w.z = pk2(v1[0], v1[1]); w.w = pk2(v1[2], v1[3]);
                    *(u32x4*)(rowp + bj * HALF) = w; }
            }
    }
};
struct EpiCqkv {
    static constexpr bool PERM = true;
    bf16_t* O; float qscale; float* out; const float* ssq; const float* biasw;
    __device__ __forceinline__ void operator()(const f32x4 (&acc)[2][2][4][2], const Unit& u, int wr, int wc, int fr, int fq) const {
        const int kv = (u.pn >> 2) - 1;
        const float sc = kv < 0 ? qscale : 1.0f;
        const int b = (u.pm * BM) >> 11; const float* bw = biasw + (size_t)b * 3072 + u.pn * BM + wc * 32 + 8 * fq;
        f32x4 bv[2][2];
#pragma unroll
        for (int bj = 0; bj < 2; ++bj) { bv[bj][0] = *(const f32x4*)(bw + bj * HALF); bv[bj][1] = *(const f32x4*)(bw + bj * HALF + 4); }
        float rs[2][4];
#pragma unroll
        for (int ai = 0; ai < 2; ++ai)
#pragma unroll
            for (int m = 0; m < 4; ++m) rs[ai][m] = ssq[u.pm * BM + ai * HALF + wr * 64 + m * 16 + fr];
#pragma unroll
        for (int ai = 0; ai < 2; ++ai)
#pragma unroll
            for (int m = 0; m < 4; ++m) {
                const int row = u.pm * BM + ai * HALF + wr * 64 + m * 16 + fr;
                const float rstd = __builtin_amdgcn_rsqf(rs[ai][m] * (1.0f / 1024.0f) + EPS);
                const int col0 = u.pn * BM + wc * 32 + 8 * fq;
                bf16_t* rowp = O + (size_t)row * 3072 + col0;
                float* fo = nullptr;
                if (kv >= 0) { const int ck = col0 - 1024 * (1 + kv); const int t = row & 2047; if (t >= 1536) fo = out + (kv ? O_CVP : O_CKP) + ((size_t)(row >> 11) * 512 + (t - 1536)) * 1024 + ck; }
#pragma unroll
                for (int bj = 0; bj < 2; ++bj) { const f32x4 v0 = (acc[ai][bj][m][0] * rstd + bv[bj][0]) * sc, v1 = (acc[ai][bj][m][1] * rstd + bv[bj][1]) * sc;
                    u32x4 w; w.x = pk2(v0[0], v0[1]); w.y = pk2(v0[2], v0[3]); w.z = pk2(v1[0], v1[1]); w.w = pk2(v1[2], v1[3]);
                    *(u32x4*)(rowp + bj * HALF) = w;
                    if (fo) { __builtin_nontemporal_store(v0, (f32x4*)(fo + bj * HALF)); __builtin_nontemporal_store(v1, (f32x4*)(fo + bj * HALF + 4)); } }
            }
    }
};
}


template <int NB>
__device__ __forceinline__ void small_core(LAS unsigned char* lds, const bf16_t* A, int lda, const bf16_t* B0, const bf16_t* B1, int K, f32x4 (&out)[NB]) {
    int tid_ = threadIdx.x; asm volatile("" : "+v"(tid_));
    const int tid = tid_, lane = tid & 63, w = __builtin_amdgcn_readfirstlane(tid >> 6), fr = lane & 15, fq = lane >> 4;
    f32x4 acc[NB][8];
#pragma unroll
    for (int nb = 0; nb < NB; ++nb)
#pragma unroll
        for (int mb = 0; mb < 8; ++mb) acc[nb][mb] = (f32x4){0.f, 0.f, 0.f, 0.f};
    const bf16_t* ap = A + (size_t)fr * lda + 8 * fq;
    const bf16_t* bp0 = B0 + (size_t)fr * K + 8 * fq;
    const bf16_t* bp1 = B1 + (size_t)fr * K + 8 * fq;
    const int nsteps = K >> 5;
    int st = w;
    for (; st + 8 < nsteps; st += 16) {
        const int k = st * 32, k2 = k + 256;
        bf16x8 b[NB], b2[NB]; b[0] = *(const bf16x8*)(bp0 + k); b2[0] = *(const bf16x8*)(bp0 + k2);
        if (NB == 2) { b[NB - 1] = *(const bf16x8*)(bp1 + k); b2[NB - 1] = *(const bf16x8*)(bp1 + k2); }
        bf16x8 a[8], a2[8];
#pragma unroll
        for (int mb = 0; mb < 8; ++mb) { a[mb] = *(const bf16x8*)(ap + (size_t)(16 * mb) * lda + k); a2[mb] = *(const bf16x8*)(ap + (size_t)(16 * mb) * lda + k2); }
#pragma unroll
        for (int mb = 0; mb < 8; ++mb)
#pragma unroll
            for (int nb = 0; nb < NB; ++nb) { acc[nb][mb] = __builtin_amdgcn_mfma_f32_16x16x32_bf16(b[nb], a[mb], acc[nb][mb], 0, 0, 0);
                acc[nb][mb] = __builtin_amdgcn_mfma_f32_16x16x32_bf16(b2[nb], a2[mb], acc[nb][mb], 0, 0, 0); }
    }
    if (st < nsteps) {
        const int k = st * 32;
        bf16x8 b[NB]; b[0] = *(const bf16x8*)(bp0 + k); if (NB == 2) b[NB - 1] = *(const bf16x8*)(bp1 + k);
        bf16x8 a[8];
#pragma unroll
        for (int mb = 0; mb < 8; ++mb) a[mb] = *(const bf16x8*)(ap + (size_t)(16 * mb) * lda + k);
#pragma unroll
        for (int mb = 0; mb < 8; ++mb)
#pragma unroll
            for (int nb = 0; nb < NB; ++nb) acc[nb][mb] = __builtin_amdgcn_mfma_f32_16x16x32_bf16(b[nb], a[mb], acc[nb][mb], 0, 0, 0);
    }
    LAS float* red = (LAS float*)lds;
    __syncthreads();
#pragma unroll
    for (int nb = 0; nb < NB; ++nb)
#pragma unroll
        for (int mb = 0; mb < 8; ++mb) *(LAS f32x4*)(red + ((w * 128 + 16 * mb + fr) * (16 * NB) + nb * 16 + 4 * fq)) = acc[nb][mb];
    __syncthreads();
    const int row = tid >> 2, c4 = (tid & 3) * 4;
#pragma unroll
    for (int nb = 0; nb < NB; ++nb) { f32x4 s = (f32x4){0.f, 0.f, 0.f, 0.f};
#pragma unroll
        for (int w8 = 0; w8 < 8; ++w8) s += *(const LAS f32x4*)(red + ((w8 * 128 + row) * (16 * NB) + nb * 16 + c4));
        out[nb] = s; }
    __syncthreads();
}
__device__ __forceinline__ void small_swiglu(LAS unsigned char* lds, const bf16_t* A, const bf16_t* Bt, bf16_t* ACT, const float* ssq, const float* biasw, int G, int c) {
    for (int un = c; un < DFF / 16; un += G) {
        const int j0 = 16 * un, rg = (j0 >> 7) * 256 + (j0 & 127);
        f32x4 o[2]; small_core<2>(lds, A, 1024, Bt + (size_t)rg * 1024, Bt + (size_t)(rg + 128) * 1024, 1024, o);
        const int row = threadIdx.x >> 2, c4 = (threadIdx.x & 3) * 4, b = 16 + (row >> 4);
        const float rstd = __builtin_amdgcn_rsqf(ssq[NP + row] * (1.0f / 1024.0f) + EPS);
        const f32x4 g = o[0] * rstd + *(const f32x4*)(biasw + (size_t)b * 5632 + rg + c4), uu = o[1] * rstd + *(const f32x4*)(biasw + (size_t)b * 5632 + rg + 128 + c4);
        u32x2 wv; wv.x = pk2(silu_f(g[0]) * uu[0], silu_f(g[1]) * uu[1]); wv.y = pk2(silu_f(g[2]) * uu[2], silu_f(g[3]) * uu[3]);
        *(u32x2*)(ACT + (size_t)(NP + row) * DFF + j0 + c4) = wv;
    }
}
__device__ __forceinline__ void small_resid(LAS unsigned char* lds, const bf16_t* A, int K, const bf16_t* Bt, const float* xs_in, float* X, const float* modp, float coef,
                                            float* ssq, const float* gs, const float* rgs, bf16_t* An, bool has_an, int G, int c) {
    for (int un = c; un < 64; un += G) {
        f32x4 o[1]; small_core<1>(lds, A, K, Bt + (size_t)(16 * un) * K, Bt, K, o);
        const int row = threadIdx.x >> 2, col = 16 * un + (threadIdx.x & 3) * 4, b = 16 + (row >> 4);
        f32x4 bs;
        if (xs_in) bs = *(const f32x4*)(xs_in + (size_t)row * DM + col);
        else { const u32x2 r_ = *(const u32x2*)(An + (size_t)(NP + row) * DM + col); const f32x4 rg = *(const f32x4*)(rgs + (size_t)b * 1024 + col);
               bs = (f32x4){bf2f(r_.x & 0xffff), bf2f(r_.x >> 16), bf2f(r_.y & 0xffff), bf2f(r_.y >> 16)} * rg; }
        const f32x4 gv = *(const f32x4*)(modp + (size_t)b * 9216 + col);
        const f32x4 xn = bs + (gv * coef) * o[0];
        float sq = xn[0] * xn[0] + xn[1] * xn[1] + xn[2] * xn[2] + xn[3] * xn[3];
        if (has_an) { const f32x4 hv = xn * *(const f32x4*)(gs + (size_t)b * 1024 + col); u32x2 wv; wv.x = pk2(hv[0], hv[1]); wv.y = pk2(hv[2], hv[3]); *(u32x2*)(An + (size_t)(NP + row) * DM + col) = wv; }
        else *(f32x4*)(X + (size_t)(NP + row) * DM + col) = xn;
        sq += __shfl_xor(sq, 1); sq += __shfl_xor(sq, 2);
        if ((threadIdx.x & 3) == 0) __hip_atomic_fetch_add(ssq + NP + row, sq, __ATOMIC_RELAXED, __HIP_MEMORY_SCOPE_AGENT);
    }
}
__device__ __forceinline__ void small_bf16(LAS unsigned char* lds, const bf16_t* A, int lda, int K, const bf16_t* Bt, int N, bf16_t* O, int ldc, float scale,
                                           const float* ssq, const float* biasw, int ldb, int G, int c) {
    for (int un = c; un < N / 16; un += G) {
        f32x4 o[1]; small_core<1>(lds, A, lda, Bt + (size_t)(16 * un) * K, Bt, K, o);
        const int row = threadIdx.x >> 2, col = 16 * un + (threadIdx.x & 3) * 4, b = 16 + (row >> 4);
        f32x4 v = o[0];
        if (ssq) v = v * __builtin_amdgcn_rsqf(ssq[NP + row] * (1.0f / 1024.0f) + EPS) + *(const f32x4*)(biasw + (size_t)b * ldb + col);
        v = v * scale; u32x2 wv; wv.x = pk2(v[0], v[1]); wv.y = pk2(v[2], v[3]);
        *(u32x2*)(O + (size_t)(NP + row) * ldc + col) = wv;
    }
}
__device__ __forceinline__ void small_cqkv(LAS unsigned char* lds, const bf16_t* A, const bf16_t* Bt, bf16_t* O, float qscale, float* out, bf16_t* KCS, bf16_t* VCS,
                                           const float* ssq, const float* biasw, int G, int c) {
    for (int un = c; un < 3072 / 16; un += G) {
        f32x4 o[1]; small_core<1>(lds, A, 1024, Bt + (size_t)(16 * un) * 1024, Bt, 1024, o);
        const int row = threadIdx.x >> 2, col = 16 * un + (threadIdx.x & 3) * 4, kv = (col >> 10) - 1, b = 16 + (row >> 4);
        const f32x4 v = (o[0] * __builtin_amdgcn_rsqf(ssq[NP + row] * (1.0f / 1024.0f) + EPS) + *(const f32x4*)(biasw + (size_t)b * 3072 + col)) * (kv < 0 ? qscale : 1.0f);
        u32x2 wv; wv.x = pk2(v[0], v[1]); wv.y = pk2(v[2], v[3]);
        *(u32x2*)(O + (size_t)(NP + row) * 3072 + col) = wv;
        if (kv >= 0) { const int ck = col - 1024 * (1 + kv), bs = row >> 4, t = row & 15;
            *(f32x4*)(out + (kv ? O_CVS : O_CKS) + ((size_t)bs * 512 + 496 + t) * 1024 + ck) = v;
            *(u32x2*)((kv ? VCS : KCS) + ((size_t)bs * LCSP + 512 + t) * 1024 + ck) = wv; }
    }
}
__device__ __forceinline__ void wave_bias(const bf16_t* A, const bf16_t* Bt, int N, float* BW, int unit, int lane) {
    const int fr = lane & 15, fq = lane >> 4;
    f32x4 a0 = (f32x4){0.f, 0.f, 0.f, 0.f}, a1 = a0;
    const bf16_t* ap = A + (size_t)fr * 1024 + 8 * fq; const bf16_t* bp = Bt + (size_t)(16 * unit + fr) * 1024 + 8 * fq;
#pragma unroll 8
    for (int k = 0; k < 1024; k += 32) { const bf16x8 bv = *(const bf16x8*)(bp + k), x0 = *(const bf16x8*)(ap + k), x1 = *(const bf16x8*)(ap + 16 * 1024 + k);
        a0 = __builtin_amdgcn_mfma_f32_16x16x32_bf16(bv, x0, a0, 0, 0, 0); a1 = __builtin_amdgcn_mfma_f32_16x16x32_bf16(bv, x1, a1, 0, 0, 0); }
    *(f32x4*)(BW + (size_t)fr * N + 16 * unit + 4 * fq) = a0;
    if (fr < 8) *(f32x4*)(BW + (size_t)(16 + fr) * N + 16 * unit + 4 * fq) = a1;
}

__device__ __forceinline__ void small_bias(LAS unsigned char* lds, const bf16_t* A, const bf16_t* Bt, int N, float* BW, int G, int c) {
    for (int un = c; un < N / 16; un += G) {
        f32x4 o[1]; small_core<1>(lds, A, 1024, Bt + (size_t)(16 * un) * 1024, Bt, 1024, o);
        const int row = threadIdx.x >> 2, col = 16 * un + (threadIdx.x & 3) * 4;
        if (row < 24) *(f32x4*)(BW + (size_t)row * N + col) = o[0];
    }
}

struct AU { const bf16_t* q; const bf16_t* k1; const bf16_t* k2; const bf16_t* v; bf16_t* o; int ldq, ldk1, ldk2, ldv; int nqw, kt0, kt1, lk, qpos0, kpos0, h; };

template <int MODE, int QB>
__device__ __forceinline__ void attn_unit(LAS unsigned char* lds, const AU& u, float lam, const float* subln_g, const LAS float* biasT) {
    constexpr int NSUB = MODE == 0 ? 2 : 1, DK1 = MODE == 2 ? 64 : 128, DK2 = MODE == 1 ? 64 : 0, DV = MODE == 2 ? 64 : 128;
    constexpr int DKT = DK1 + DK2, DQK = DKT / NSUB, KSTRB = (DKT + 8) * 2, VSTRB = DV * 2 + 32;
    constexpr int NKK = DQK / 32, NDB = DV / 16, BAND = MODE == 2 ? 8 : (1 << 20);
    constexpr int C1 = DK1 / 8, N1 = 64 * C1 / 512, CV = DV / 8, NV = 64 * CV / 512;
    constexpr int BUFB = 64 * KSTRB + 64 * VSTRB;
    constexpr int RW = 16 * QB;
    const int tid = threadIdx.x, lane = tid & 63, w = __builtin_amdgcn_readfirstlane(tid >> 6), r = lane & 15, g = lane >> 4;
    const bool active = w < u.nqw;
    const int qpos = u.qpos0 + RW * w + r;
    bf16x8 qf[QB][NSUB][NKK];
    if (active) {
#pragma unroll
        for (int j = 0; j < QB; ++j) {
            const bf16_t* qp = u.q + (size_t)(RW * w + 16 * j + r) * u.ldq;
#pragma unroll
            for (int s = 0; s < NSUB; ++s)
#pragma unroll
                for (int kk = 0; kk < NKK; ++kk) qf[j][s][kk] = *(const bf16x8*)(qp + s * DQK + 32 * kk + 8 * g);
            if (MODE == 1) {
#pragma unroll
                for (int i = 0; i < 8; ++i) {
                    const int d = 8 * g + i; const float inv = __builtin_amdgcn_exp2f(-(float)d * (13.287712379549449f / 32.0f));
                    const float ang_ = (float)(qpos + 16 * j) * inv; const float sn = __sinf(ang_), cs = __cosf(ang_);
                    const float x1 = bf2f((unsigned short)qf[j][0][NKK - 2][i]), x2 = bf2f((unsigned short)qf[j][0][NKK - 1][i]);
                    const unsigned pr = pk2(x1 * cs - x2 * sn, x2 * cs + x1 * sn);
                    qf[j][0][NKK - 2][i] = (short)(pr & 0xffff); qf[j][0][NKK - 1][i] = (short)(pr >> 16);
                }
            }
        }
    } else {
#pragma unroll
        for (int j = 0; j < QB; ++j)
#pragma unroll
            for (int s = 0; s < NSUB; ++s)
#pragma unroll
                for (int kk = 0; kk < NKK; ++kk) qf[j][s][kk] = (bf16x8){0, 0, 0, 0, 0, 0, 0, 0};
    }
    float mrun[QB][NSUB], lrun[QB][NSUB]; f32x4 O[QB][NSUB][NDB];
#pragma unroll
    for (int j = 0; j < QB; ++j)
#pragma unroll
        for (int s = 0; s < NSUB; ++s) { mrun[j][s] = -INFINITY; lrun[j][s] = 0.f;
#pragma unroll
            for (int db = 0; db < NDB; ++db) O[j][s][db] = (f32x4){0.f, 0.f, 0.f, 0.f}; }
    const int cw = (u.qpos0 + RW * w) >> 6, ck0 = u.kpos0 >> 6;
    u32x4 rk1[N1], rv[NV], rk2;
    const int li = lane & 15, tq = li >> 2, tp = li & 3;
#define ATT_LOAD(kt) do { \
        _Pragma("unroll") for (int i = 0; i < N1; ++i) { const int c = tid + 512 * i, row = c / C1, cc = c % C1; rk1[i] = *(const u32x4*)(u.k1 + (size_t)(64 * (kt) + row) * u.ldk1 + cc * 8); } \
        if (MODE == 1) { const int row = tid >> 3, cc = tid & 7; rk2 = *(const u32x4*)(u.k2 + (size_t)(64 * (kt) + row) * u.ldk2 + cc * 8); } \
        _Pragma("unroll") for (int i = 0; i < NV; ++i) { const int c = tid + 512 * i, row = c / CV, cc = c % CV; rv[i] = *(const u32x4*)(u.v + (size_t)(64 * (kt) + row) * u.ldv + cc * 8); } } while (0)
#define ATT_STORE(bb) do { LAS unsigned char* Ks = lds + (bb) * BUFB; LAS unsigned char* Vs = Ks + 64 * KSTRB; \
        _Pragma("unroll") for (int i = 0; i < N1; ++i) { const int c = tid + 512 * i, row = c / C1, cc = c % C1; *(LAS u32x4*)(Ks + row * KSTRB + cc * 16) = rk1[i]; } \
        if (MODE == 1) { const int row = tid >> 3, cc = tid & 7; *(LAS u32x4*)(Ks + row * KSTRB + DK1 * 2 + cc * 16) = rk2; } \
        _Pragma("unroll") for (int i = 0; i < NV; ++i) { const int c = tid + 512 * i, row = c / CV, cc = c % CV; *(LAS u32x4*)(Vs + row * VSTRB + cc * 16) = rv[i]; } } while (0)
    ATT_LOAD(u.kt0);
    ATT_STORE(0);
    if (u.kt0 + 1 < u.kt1) ATT_LOAD(u.kt0 + 1);
    asm volatile("s_waitcnt lgkmcnt(0)\n\ts_barrier" ::: "memory");
    for (int kt = u.kt0; kt < u.kt1; ++kt) {
        const int cur = (kt - u.kt0) & 1;
        if (kt + 1 < u.kt1) { ATT_STORE(cur ^ 1); if (kt + 2 < u.kt1) ATT_LOAD(kt + 2); }
        const LAS unsigned char* Ks = lds + cur * BUFB; const LAS unsigned char* Vs = Ks + 64 * KSTRB;
        const int ck = ck0 + kt;
        if (active && ck <= cw && ck >= cw - BAND) {
            f32x4 S[QB][NSUB][4];
#pragma unroll
            for (int s = 0; s < NSUB; ++s)
#pragma unroll
                for (int kb = 0; kb < 4; ++kb) {
#pragma unroll
                    for (int j = 0; j < QB; ++j) S[j][s][kb] = (f32x4){0.f, 0.f, 0.f, 0.f};
#pragma unroll
                    for (int kk = 0; kk < NKK; ++kk) { const bf16x8 kf = *(const LAS bf16x8*)(Ks + (16 * kb + r) * KSTRB + (s * DQK + 32 * kk + 8 * g) * 2);
#pragma unroll
                        for (int j = 0; j < QB; ++j) S[j][s][kb] = __builtin_amdgcn_mfma_f32_16x16x32_bf16(kf, qf[j][s][kk], S[j][s][kb], 0, 0, 0); } }
            if (MODE == 2) {
                if (u.kpos0 + 64 * kt + 63 - (u.qpos0 + RW * w) <= -128) {
                    const float bc = biasT[u.h * 257];
#pragma unroll
                    for (int j = 0; j < QB; ++j)
#pragma unroll
                        for (int kb = 0; kb < 4; ++kb) S[j][0][kb] += bc;
                } else {
#pragma unroll
                    for (int j = 0; j < QB; ++j) {
                        const int kp0 = u.kpos0 + 64 * kt + 4 * g - (qpos + 16 * j);
#pragma unroll
                        for (int kb = 0; kb < 4; ++kb)
#pragma unroll
                            for (int e = 0; e < 4; ++e) { int d = kp0 + 16 * kb + e; d = d < -128 ? -128 : (d > 128 ? 128 : d); S[j][0][kb][e] += biasT[u.h * 257 + d + 128]; }
                    }
                }
            }
            if (__builtin_expect((kt + 1) * 64 > u.lk, 0)) {
                asm volatile("" ::: "memory");
#pragma unroll
                for (int j = 0; j < QB; ++j)
#pragma unroll
                    for (int s = 0; s < NSUB; ++s)
#pragma unroll
                        for (int kb = 0; kb < 4; ++kb)
#pragma unroll
                            for (int e = 0; e < 4; ++e) if (64 * kt + 16 * kb + 4 * g + e >= u.lk) S[j][s][kb][e] = -INFINITY;
            }
            bf16x8 pf[QB][NSUB][2];
#pragma unroll
            for (int j = 0; j < QB; ++j)
#pragma unroll
                for (int s = 0; s < NSUB; ++s) {
                    float mx = fmaxf(fmaxf(S[j][s][0][0], S[j][s][0][1]), fmaxf(S[j][s][0][2], S[j][s][0][3]));
#pragma unroll
                    for (int kb = 1; kb < 4; ++kb) mx = fmaxf(mx, fmaxf(fmaxf(S[j][s][kb][0], S[j][s][kb][1]), fmaxf(S[j][s][kb][2], S[j][s][kb][3])));
                    mx = rows_max(mx);
                    const float mn = fmaxf(mrun[j][s], mx), alpha = __builtin_amdgcn_exp2f(mrun[j][s] - mn); mrun[j][s] = mn;
                    float ps = 0.f;
#pragma unroll
                    for (int kb = 0; kb < 4; ++kb)
#pragma unroll
                        for (int e = 0; e < 4; ++e) { const float pe = __builtin_amdgcn_exp2f(S[j][s][kb][e] - mn); S[j][s][kb][e] = pe; ps += pe; }
                    if (__builtin_amdgcn_ballot_w64(alpha != 1.0f) != 0ull) { lrun[j][s] *= alpha;
#pragma unroll
                        for (int db = 0; db < NDB; ++db) O[j][s][db] *= alpha; }
                    lrun[j][s] += ps;
#pragma unroll
                    for (int kc = 0; kc < 2; ++kc) { u32x4 pw; pw.x = pk2(S[j][s][2 * kc][0], S[j][s][2 * kc][1]); pw.y = pk2(S[j][s][2 * kc][2], S[j][s][2 * kc][3]);
                        pw.z = pk2(S[j][s][2 * kc + 1][0], S[j][s][2 * kc + 1][1]); pw.w = pk2(S[j][s][2 * kc + 1][2], S[j][s][2 * kc + 1][3]); pf[j][s][kc] = __builtin_bit_cast(bf16x8, pw); }
                }
#pragma unroll
            for (int db = 0; db < NDB; ++db) {
                bf16x8 vf[2];
#pragma unroll
                for (int kc = 0; kc < 2; ++kc) {
                    const LAS unsigned char* vp = Vs + (32 * kc + 4 * g + tq) * VSTRB + (16 * db + 4 * tp) * 2;
                    const s16x4 lo = __builtin_bit_cast(s16x4, __builtin_amdgcn_ds_read_tr16_b64_v4i16((LAS s16x4*)vp));
                    const s16x4 hi = __builtin_bit_cast(s16x4, __builtin_amdgcn_ds_read_tr16_b64_v4i16((LAS s16x4*)(vp + 16 * VSTRB)));
                    vf[kc] = (bf16x8){lo[0], lo[1], lo[2], lo[3], hi[0], hi[1], hi[2], hi[3]};
                }
#pragma unroll
                for (int j = 0; j < QB; ++j)
#pragma unroll
                    for (int s = 0; s < NSUB; ++s)
#pragma unroll
                        for (int kc = 0; kc < 2; ++kc) O[j][s][db] = __builtin_amdgcn_mfma_f32_16x16x32_bf16(vf[kc], pf[j][s][kc], O[j][s][db], 0, 0, 0);
            }
        }
        asm volatile("s_waitcnt lgkmcnt(0)\n\ts_barrier" ::: "memory");
    }
#undef ATT_LOAD
#undef ATT_STORE
    if (active) {
#pragma unroll
        for (int j = 0; j < QB; ++j) {
            float li_[NSUB];
#pragma unroll
            for (int s = 0; s < NSUB; ++s) { const float l = rows_sum(lrun[j][s]); li_[s] = 1.0f / l; }
            bf16_t* op = u.o + (size_t)(RW * w + 16 * j + r) * DM + 4 * g;
            if (MODE == 0) {
                float ss = 0.f;
#pragma unroll
                for (int db = 0; db < NDB; ++db) { O[j][0][db] = O[j][0][db] * li_[0] - (O[j][NSUB - 1][db] * li_[NSUB - 1]) * lam;
                    ss += O[j][0][db][0] * O[j][0][db][0] + O[j][0][db][1] * O[j][0][db][1] + O[j][0][db][2] * O[j][0][db][2] + O[j][0][db][3] * O[j][0][db][3]; }
                ss = rows_sum(ss);
                const float rstd = 1.0f / sqrtf(ss * (1.0f / 128.0f) + EPS) * (1.0f - LAM_INIT);
#pragma unroll
                for (int db = 0; db < NDB; ++db) { const f32x4 gg = *(const f32x4*)(subln_g + 16 * db + 4 * g); const f32x4 v = O[j][0][db] * rstd * gg;
                    u32x2 wv; wv.x = pk2(v[0], v[1]); wv.y = pk2(v[2], v[3]); *(u32x2*)(op + 16 * db) = wv; }
            } else {
#pragma unroll
                for (int db = 0; db < NDB; ++db) { const f32x4 v = O[j][0][db] * li_[0]; u32x2 wv; wv.x = pk2(v[0], v[1]); wv.y = pk2(v[2], v[3]); *(u32x2*)(op + 16 * db) = wv; }
            }
        }
    }
}

__device__ __forceinline__ void transpose_item(const float* W, int K, int Nsrc, int Nd, bf16_t* WT, int mode, LAS float* scr, int item, int lane) {
    const int nblk = Nd / 32, kb = item / nblk, nb = item % nblk, k0 = 64 * kb, n0 = 32 * nb;
    int sc0 = n0; bool zero = false;
    if (mode == 1) { const int pn = n0 >> 8, bj = (n0 >> 7) & 1, i0 = n0 & 127; sc0 = bj * DFF + 128 * pn + i0; }
    else zero = (n0 >= Nsrc);
    float v_[32];
    const float* wp_ = W + (size_t)(k0 + (lane >> 5)) * Nsrc + sc0 + (lane & 31);
#pragma unroll
    for (int i = 0; i < 32; ++i) v_[i] = zero ? 0.f : wp_[(size_t)(2 * i) * Nsrc];
#pragma unroll
    for (int i = 0; i < 32; ++i) scr[(2 * i + (lane >> 5)) * 33 + (lane & 31)] = v_[i];
    asm volatile("s_waitcnt lgkmcnt(0)" ::: "memory");
    const int c = lane & 7;
#pragma unroll
    for (int j = 0; j < 4; ++j) { const int n = (lane >> 3) + 8 * j; const LAS float* s = scr + (8 * c) * 33 + n;
        u32x4 o; o.x = pk2(s[0 * 33], s[1 * 33]); o.y = pk2(s[2 * 33], s[3 * 33]); o.z = pk2(s[4 * 33], s[5 * 33]); o.w = pk2(s[6 * 33], s[7 * 33]);
        __builtin_nontemporal_store(o, (u32x4*)(WT + (size_t)(n0 + n) * K + k0 + 8 * c)); }
    asm volatile("s_waitcnt lgkmcnt(0)" ::: "memory");
}
__device__ __forceinline__ void conv_rows(const float* src, bf16_t* dst, int B, int R, int C, int dstB, int dstOff, int gtid, int gthreads) {
    const int c4 = C / 4; const long total = (long)B * R * c4;
    for (long i = gtid; i < total; i += gthreads) { const int cc = (int)(i % c4); const long br = i / c4; const int rr = (int)(br % R), b = (int)(br / R);
        const f32x4 v = *(const f32x4*)(src + ((size_t)br * C + cc * 4)); u32x2 o; o.x = pk2(v[0], v[1]); o.y = pk2(v[2], v[3]);
        __builtin_nontemporal_store(o, (u32x2*)(dst + ((size_t)(b * dstB + dstOff + rr) * C + cc * 4))); }
}
__device__ __forceinline__ void zero_rows(bf16_t* dst, int B, int R, int C, int dstB, int dstOff, int gtid, int gthreads) {
    const int c4 = C / 4; const long total = (long)B * R * c4;
    for (long i = gtid; i < total; i += gthreads) { const int cc = (int)(i % c4); const long br = i / c4; const int rr = (int)(br % R), b = (int)(br / R);
        *(u32x2*)(dst + ((size_t)(b * dstB + dstOff + rr) * C + cc * 4)) = (u32x2){0u, 0u}; }
}


#define XB_TMO      128
#define XB_XCNT(j)  (256  + 64 * (j))
#define XB_XSUB(j)  (1280 + 64 * (j))
#define XB_XGEN(j)  (2304 + 64 * (j))
#define XB_TOP      3328
#define XB_TOPGEN   3392
#define XCD_BAR_WORDS 3456
#define XB_SPIN_CAP (1u << 18)
__device__ __forceinline__ unsigned xb_ld(unsigned* p)              { return __hip_atomic_load(p, __ATOMIC_RELAXED, __HIP_MEMORY_SCOPE_AGENT); }
__device__ __forceinline__ unsigned xb_add(unsigned* p, unsigned v) { return __hip_atomic_fetch_add(p, v, __ATOMIC_RELAXED, __HIP_MEMORY_SCOPE_AGENT); }
__device__ __forceinline__ unsigned xb_xcc_id() { return (unsigned)__builtin_amdgcn_s_getreg((3 << 11) | 20) & 0xFu; }
#define XB_SPIN(cond, bar) do { unsigned _sp = 0; while (cond) { __builtin_amdgcn_s_sleep(1); \
    if ((++_sp & 255u) == 0u) { if (xb_ld(&(bar)[XB_TMO])) break; if (_sp > XB_SPIN_CAP) { atomicAdd(&(bar)[XB_TMO], 1u); break; } } } } while (0)
struct XcdBarrier { unsigned* bar; unsigned x; volatile LAS unsigned* st; };
__device__ __forceinline__ XcdBarrier xcd_barrier_post(unsigned* bar, volatile LAS unsigned* st) {
    XcdBarrier b; b.bar = bar; b.x = xb_xcc_id(); b.st = st;
    if (threadIdx.x == 0) (void)xb_add(&bar[XB_XCNT(b.x)], 1u);
    return b;
}
__device__ __forceinline__ void xcd_barrier_complete(unsigned* bar, unsigned x, unsigned& nloc, unsigned& nx) {
    const unsigned G = gridDim.x * gridDim.y * gridDim.z;
    unsigned sum, cnt, mine, sp = 0u;
    for (;;) {
        sum = 0u; cnt = 0u; mine = 0u;
#pragma unroll
        for (unsigned j = 0; j < 16; ++j) { const unsigned c = xb_ld(&bar[XB_XCNT(j)]); sum += c; cnt += (c > 0u) ? 1u : 0u; mine = (j == x) ? c : mine; }
        if (sum == G) break;
        __builtin_amdgcn_s_sleep(1);
        if ((++sp & 255u) == 0u) { if (xb_ld(&bar[XB_TMO])) break; if (sp > XB_SPIN_CAP) { atomicAdd(&bar[XB_TMO], 1u); break; } }
    }
    nloc = mine > 0u ? mine : 1u; nx = cnt > 0u ? cnt : 1u;
}
__device__ __forceinline__ void xcd_barrier(const XcdBarrier& b) {
    asm volatile("s_waitcnt vmcnt(0)" ::: "memory");
    __syncthreads();
    if (threadIdx.x == 0) {
        unsigned* bar = b.bar;
        __builtin_amdgcn_s_waitcnt(0);
        unsigned nloc = b.st[0], nx = b.st[1];
        if (nloc == 0u) { xcd_barrier_complete(bar, b.x, nloc, nx); b.st[0] = nloc; b.st[1] = nx; }
        const unsigned old = xb_add(&bar[XB_XSUB(b.x)], 1u);
        const unsigned gen = old / nloc;
        if (old + 1u == (gen + 1u) * nloc) {
            __builtin_amdgcn_fence(__ATOMIC_RELEASE, "agent");
            asm volatile("s_waitcnt vmcnt(0)" ::: "memory");
            const unsigned og = xb_add(&bar[XB_TOP], 1u);
            const unsigned tg = og / nx;
            if (og + 1u == (tg + 1u) * nx) xb_add(&bar[XB_TOPGEN], 1u);
            else XB_SPIN(xb_ld(&bar[XB_TOPGEN]) == tg, bar);
            __builtin_amdgcn_fence(__ATOMIC_ACQUIRE, "agent");
            xb_add(&bar[XB_XGEN(b.x)], 1u);
            asm volatile("s_waitcnt vmcnt(0)" ::: "memory");
        } else {
            XB_SPIN(xb_ld(&bar[XB_XGEN(b.x)]) == gen, bar);
            __builtin_amdgcn_fence(__ATOMIC_ACQUIRE, "agent");
            asm volatile("s_waitcnt vmcnt(0)" ::: "memory");
        }
    }
    __syncthreads();
}

__global__ void __launch_bounds__(512, 2) fwd_kernel(Params P) {
    extern __shared__ __attribute__((aligned(16))) unsigned char lds_raw[];
    LAS unsigned char* lds = (LAS unsigned char*)lds_raw;
    cg::grid_group grid = cg::this_grid();
    const int tid = threadIdx.x, lane = tid & 63, wave = __builtin_amdgcn_readfirstlane(tid >> 6);
    const int G = gridDim.x, c = blockIdx.x;
    const int gw = c * 8 + wave, NGW = G * 8, gtid = c * 512 + tid, gthreads = G * 512;
    unsigned char* ws = P.ws;
    float* OUT = P.out;
    float* MOD = (float*)(ws + OFF_MOD);
    bf16_t* WFI = (bf16_t*)(ws + OFF_WFI); bf16_t* WFO = (bf16_t*)(ws + OFF_WFO); bf16_t* WABI = (bf16_t*)(ws + OFF_WABI);
    bf16_t* WUQ = (bf16_t*)(ws + OFF_WUQ); bf16_t* WUKV = (bf16_t*)(ws + OFF_WUKV); bf16_t* WABO = (bf16_t*)(ws + OFF_WABO);
    bf16_t* WCI = (bf16_t*)(ws + OFF_WCI); bf16_t* WCO = (bf16_t*)(ws + OFF_WCO);
    bf16_t* H = (bf16_t*)(ws + OFF_H); bf16_t* BIG = (bf16_t*)(ws + OFF_BIG); bf16_t* BQ = (bf16_t*)(ws + OFF_BQ);
    bf16_t* KV = (bf16_t*)(ws + OFF_KV); bf16_t* LAT = (bf16_t*)(ws + OFF_LAT); bf16_t* KR = (bf16_t*)(ws + OFF_KR);
    bf16_t* KAS = (bf16_t*)(ws + OFF_KAS); bf16_t* VAS = (bf16_t*)(ws + OFF_VAS); bf16_t* KCS = (bf16_t*)(ws + OFF_KCS); bf16_t* VCS = (bf16_t*)(ws + OFF_VCS);
    const float* xp = P.in[0]; const float* xs = P.in[1];
    if (tid == 0) { ((LAS unsigned*)(lds + 131072))[0] = 0u; ((LAS unsigned*)(lds + 131072))[1] = 0u; }
    __syncthreads();
    const XcdBarrier xb = xcd_barrier_post((unsigned*)(ws + OFF_BAR), (volatile LAS unsigned*)(lds + 131072));
    float* RGS = (float*)(ws + OFF_RGS); float* GS = (float*)(ws + OFF_GS); bf16_t* SHB = (bf16_t*)(ws + OFF_SHB); float* BW = (float*)(ws + OFF_BW); float* SSQ = (float*)(ws + OFF_SSQ);
    float* BWAB = BW + 4 * 24 * 5632; float* BWC = BWAB + 24 * 2304;
    bf16_t* OAB = (bf16_t*)(P.out + O_CKP);
    bf16_t* OC = KV;

    {
        LAS float* scr = (LAS float*)(lds + wave * 8448);
        constexpr int I_FI = 16 * 176, I_FO = 44 * 32, I_ABI = 16 * 72, I_UQ = 6 * 24, I_UKV = 4 * 32, I_SQ = 16 * 32, I_CI = 16 * 96;
        constexpr int NITEMS0 = 2 * I_FI + 2 * I_FO + I_ABI + I_UQ + I_UKV + I_SQ;
        for (int it = gw; it < NITEMS0; it += NGW) {
            int r = it;
            if (r < 2 * I_FI) { const int mi = r / I_FI; transpose_item(P.in[13] + (size_t)mi * 1024 * 5632, 1024, 5632, 5632, WFI + (size_t)mi * 5632 * 1024, 1, scr, r % I_FI, lane); continue; } r -= 2 * I_FI;
            if (r < 2 * I_FO) { const int mi = r / I_FO; transpose_item(P.in[14] + (size_t)mi * 2816 * 1024, 2816, 1024, 1024, WFO + (size_t)mi * 1024 * 2816, 0, scr, r % I_FO, lane); continue; } r -= 2 * I_FO;
            if (r < I_ABI) { transpose_item(P.in[15], 1024, 2240, 2304, WABI, 0, scr, r, lane); continue; } r -= I_ABI;
            if (r < I_UQ) { transpose_item(P.in[19], 384, 768, 768, WUQ, 0, scr, r, lane); continue; } r -= I_UQ;
            if (r < I_UKV) { transpose_item(P.in[21], 256, 1024, 1024, WUKV, 0, scr, r, lane); continue; } r -= I_UKV;
            transpose_item(P.in[22], 1024, 1024, 1024, WABO, 0, scr, r, lane);
        }
        conv_rows(P.in[2], KAS, 8, 1024, 512, LKSP, 0, gtid, gthreads);
        conv_rows(P.in[3], VAS, 8, 1024, 512, LKSP, 0, gtid, gthreads);
        conv_rows(P.in[4], LAT + (size_t)NP * 256, 8, 1024, 256, LKSP, 0, gtid, gthreads);
        conv_rows(P.in[5], KR + (size_t)NP * 64, 8, 1024, 64, LKSP, 0, gtid, gthreads);
        conv_rows(P.in[6], KCS, 8, 512, 1024, LCSP, 0, gtid, gthreads);
        conv_rows(P.in[7], VCS, 8, 512, 1024, LCSP, 0, gtid, gthreads);
        zero_rows(KAS, 8, 48, 512, LKSP, LKS, gtid, gthreads);
        zero_rows(VAS, 8, 48, 512, LKSP, LKS, gtid, gthreads);
        zero_rows(LAT + (size_t)NP * 256, 8, 48, 256, LKSP, LKS, gtid, gthreads);
        zero_rows(KR + (size_t)NP * 64, 8, 48, 64, LKSP, LKS, gtid, gthreads);
        zero_rows(KCS, 8, 48, 1024, LCSP, LCS, gtid, gthreads);
        zero_rows(VCS, 8, 48, 1024, LCSP, LCS, gtid, gthreads);
        for (int i = gtid; i < 6 * 33024; i += gthreads) SSQ[33024 + i] = 0.f;
        __syncthreads();
        LAS float* sc = (LAS float*)lds;
        for (int un = c; un < 288; un += G) {
            __syncthreads();
            for (int i = tid; i < 24 * 1024; i += 512) { const int b = i >> 10, k = i & 1023; const float v = b < 16 ? P.in[8][b * 1024 + k] : P.in[9][(b - 16) * 1024 + k];
                sc[k * 24 + b] = v / (1.0f + __expf(-v)); }
            __syncthreads();
            const int l = un / 144, n0 = (un % 144) * 64, col = n0 + lane;
            const float* Wp = P.in[10] + (size_t)l * 1024 * 9216 + col;
            float acc[24];
#pragma unroll
            for (int b = 0; b < 24; ++b) acc[b] = 0.f;
#pragma unroll 16
            for (int k = wave * 128; k < wave * 128 + 128; ++k) { const float wv = Wp[(size_t)k * 9216];
#pragma unroll
                for (int b4 = 0; b4 < 6; ++b4) { const f32x4 s4 = *(const LAS f32x4*)(sc + k * 24 + b4 * 4); acc[b4 * 4 + 0] += s4[0] * wv; acc[b4 * 4 + 1] += s4[1] * wv; acc[b4 * 4 + 2] += s4[2] * wv; acc[b4 * 4 + 3] += s4[3] * wv; } }
            __syncthreads();
            LAS float* red = (LAS float*)lds;
#pragma unroll
            for (int b = 0; b < 24; ++b) red[(wave * 24 + b) * 64 + lane] = acc[b];
            __syncthreads();
            for (int i = tid; i < 24 * 64; i += 512) { const int b = i >> 6, cl = i & 63; float s = P.in[11][l * 9216 + n0 + cl];
#pragma unroll
                for (int w8 = 0; w8 < 8; ++w8) s += red[(w8 * 24 + b) * 64 + cl];
                MOD[((size_t)l * 24 + b) * 9216 + n0 + cl] = s;
                const int n = n0 + cl, slot = n >> 10; if (slot == 0 || slot == 3 || slot == 6) SHB[((size_t)(l * 3 + slot / 3) * 128 + b) * 1024 + (n & 1023)] = (bf16_t)(pk2(s, 0.f) & 0xffff); }
        }
    }
    grid.sync();

    float* X = OUT;
    {
        const float* gsl = P.in[12]; const float* mdl = MOD + 1024;
        for (int row = gw; row < MR; row += NGW) {
            const float* xr = row < NP ? xp + (size_t)row * DM : xs + (size_t)(row - NP) * DM;
            const int b = row_batch(row); f32x4 v[4]; float ss = 0.f;
#pragma unroll
            for (int j = 0; j < 4; ++j) { v[j] = *(const f32x4*)(xr + 4 * lane + 256 * j); ss += v[j][0] * v[j][0] + v[j][1] * v[j][1] + v[j][2] * v[j][2] + v[j][3] * v[j][3]; }
            ss = wave_sum(ss); if (lane == 0) SSQ[row] = ss;
#pragma unroll
            for (int j = 0; j < 4; ++j) { const int col = 4 * lane + 256 * j; const f32x4 gg = *(const f32x4*)(gsl + col); const f32x4 scl = *(const f32x4*)(mdl + (size_t)b * 9216 + col);
                const f32x4 hv = v[j] * gg * (scl + 1.0f); u32x2 o; o.x = pk2(hv[0], hv[1]); o.y = pk2(hv[2], hv[3]); *(u32x2*)(H + (size_t)row * DM + col) = o; }
        }
        for (int i = gtid; i < 6 * 24 * 1024; i += gthreads) { const int col = i & 1023, b = (i >> 10) % 24, inst = i / (24 * 1024), l = inst / 3, sub = inst % 3;
            const float gsv_ = P.in[12][inst * 1024 + col] * (1.0f + MOD[((size_t)l * 24 + b) * 9216 + (3 * sub + 1) * 1024 + col]); GS[i] = gsv_; RGS[i] = fabsf(gsv_) > 1e-20f ? 1.0f / gsv_ : 0.0f; }
        for (int i = gtid; i < 24 * 1024; i += gthreads) GS[6 * 24 * 1024 + i] = P.in[26][i & 1023];
        for (int un = gw; un < 848; un += NGW) {
            int r = un;
            if (r < 704) { const int mi = r / 352, inst = mi == 0 ? 0 : 2; wave_bias(SHB + (size_t)inst * 128 * 1024, WFI + (size_t)mi * 5632 * 1024, 5632, BW + (size_t)mi * 24 * 5632, r % 352, lane); continue; } r -= 704;
            wave_bias(SHB + (size_t)1 * 128 * 1024, WABI, 2304, BWAB, r, lane);
        }
    }
    xcd_barrier(xb);

#define FFN_PHASES(L, S2, FROM_IN, SSQ_IN, BW_IN, SSQ_OUT, GS_OUT, RGS_PREV, HASAN) do { \
        { small_swiglu(lds, H + (size_t)NP * DM, WFI + (size_t)((L) * 2 + (S2)) * 5632 * 1024, BIG, SSQ_IN, BW_IN, G, c); \
          pg8::Gemm gg_{H, WFI + (size_t)((L) * 2 + (S2)) * 5632 * 1024, NP, 5632, 1024, 1024}; pg8::StaticOrder so_; so_.init(NP, 5632, G, c); \
          pg8::EpiSwiglu e_{BIG, SSQ_IN, BW_IN}; pg8::gemm_phase(lds, gg_, so_, e_); } \
        xcd_barrier(xb); \
        { small_resid(lds, BIG + (size_t)NP * DFF, 2816, WFO + (size_t)((L) * 2 + (S2)) * 1024 * 2816, (FROM_IN) ? xs : nullptr, X, MOD + (size_t)(L) * 24 * 9216 + (3 * (2 * (S2)) + 2) * 1024, 0.5f, SSQ_OUT, GS_OUT, RGS_PREV, H, HASAN, G, c); \
          pg8::Gemm gg_{BIG, WFO + (size_t)((L) * 2 + (S2)) * 1024 * 2816, NP, 1024, 2816, 2816}; pg8::StaticOrder so_; so_.init(NP, 1024, G, c); \
          pg8::EpiResid<HASAN, FROM_IN> e_{xp, X, MOD + (size_t)(L) * 24 * 9216 + (3 * (2 * (S2)) + 2) * 1024, 0.5f, SSQ_OUT, GS_OUT, RGS_PREV, H}; pg8::gemm_phase(lds, gg_, so_, e_); } \
        xcd_barrier(xb); } while (0)

    FFN_PHASES(0, 0, false, SSQ, (BW + 0 * 24 * 5632), SSQ + 1 * 33024, GS + 1 * 24 * 1024, RGS, true);
    {
        small_bf16(lds, H + (size_t)NP * DM, 1024, 1024, WABI, 2240, BIG, PROJ_LD, 1.0f, SSQ + 1 * 33024, BWAB, 2304, G, (c + 128) % G);
        pg8::Gemm gg_{H, WABI, NP, 2304, 1024, 1024}; pg8::StaticOrder so_; so_.init(NP, 2304, G, c);
        pg8::EpiBf16<true> e_{BIG, PROJ_LD, 1.0f, SSQ + 1 * 33024, BWAB, 2304}; pg8::gemm_phase(lds, gg_, so_, e_);
    }
    xcd_barrier(xb);
    {
        const float* qng = P.in[18]; const float* kvg = P.in[20];
        const int dsub = (lane & 3) * 8; const bool ishi = (lane & 4) != 0;
        for (int row = gw; row < MR; row += NGW) {
            bf16_t* pr = BIG + (size_t)row * PROJ_LD;
            const int pos = row_pos(row);
            float cs[8], sn[8];
#pragma unroll
            for (int i = 0; i < 8; ++i) { const float inv = __builtin_amdgcn_exp2f(-(float)(dsub + i) * (13.287712379549449f / 32.0f)); const float ang_ = (float)pos * inv; sn[i] = __sinf(ang_); cs[i] = __cosf(ang_); }
            { const u32x4 raw = *(const u32x4*)(pr + lane * 8); float x[8], y[8];
#pragma unroll
              for (int i = 0; i < 4; ++i) { x[2 * i] = bf2f(raw[i] & 0xffff); x[2 * i + 1] = bf2f(raw[i] >> 16); }
#pragma unroll
              for (int i = 0; i < 8; ++i) { const float o = __shfl_xor(x[i], 4); y[i] = (ishi ? (x[i] * cs[i] + o * sn[i]) : (x[i] * cs[i] - o * sn[i])) * (0.125f * LOG2E); }
              u32x4 wv; wv.x = pk2(y[0], y[1]); wv.y = pk2(y[2], y[3]); wv.z = pk2(y[4], y[5]); wv.w = pk2(y[6], y[7]); *(u32x4*)(pr + lane * 8) = wv; }
            { const u32x4 raw = *(const u32x4*)(pr + 512 + lane * 8); float x[8], y[8];
#pragma unroll
              for (int i = 0; i < 4; ++i) { x[2 * i] = bf2f(raw[i] & 0xffff); x[2 * i + 1] = bf2f(raw[i] >> 16); }
#pragma unroll
              for (int i = 0; i < 8; ++i) { const float o = __shfl_xor(x[i], 4); y[i] = ishi ? (x[i] * cs[i] + o * sn[i]) : (x[i] * cs[i] - o * sn[i]); }
              float* fo = OUT + O_AK + (size_t)row * 512 + lane * 8; __builtin_nontemporal_store((f32x4){y[0], y[1], y[2], y[3]}, (f32x4*)fo); __builtin_nontemporal_store((f32x4){y[4], y[5], y[6], y[7]}, (f32x4*)(fo + 4));
              u32x4 wv; wv.x = pk2(y[0], y[1]); wv.y = pk2(y[2], y[3]); wv.z = pk2(y[4], y[5]); wv.w = pk2(y[6], y[7]);
              if (row < NP) *(u32x4*)(pr + 512 + lane * 8) = wv;
              else { const int bs = (row - NP) >> 4, t = (row - NP) & 15; *(u32x4*)(KAS + ((size_t)bs * LKSP + 1024 + t) * 512 + lane * 8) = wv; } }
            { const u32x4 raw = *(const u32x4*)(pr + 1024 + lane * 8); float x[8];
#pragma unroll
              for (int i = 0; i < 4; ++i) { x[2 * i] = bf2f(raw[i] & 0xffff); x[2 * i + 1] = bf2f(raw[i] >> 16); }
              float* fo = OUT + O_AV + (size_t)row * 512 + lane * 8; __builtin_nontemporal_store((f32x4){x[0], x[1], x[2], x[3]}, (f32x4*)fo); __builtin_nontemporal_store((f32x4){x[4], x[5], x[6], x[7]}, (f32x4*)(fo + 4));
              if (row >= NP) { const int bs = (row - NP) >> 4, t = (row - NP) & 15; *(u32x4*)(VAS + ((size_t)bs * LKSP + 1024 + t) * 512 + lane * 8) = raw; } }
            { float x[8]; u32x4 raw = (u32x4){0u, 0u, 0u, 0u}; if (lane < 48) raw = *(const u32x4*)(pr + 1536 + lane * 8);
              float ss = 0.f;
#pragma unroll
              for (int i = 0; i < 4; ++i) { x[2 * i] = bf2f(raw[i] & 0xffff); x[2 * i + 1] = bf2f(raw[i] >> 16); ss += x[2 * i] * x[2 * i] + x[2 * i + 1] * x[2 * i + 1]; }
              const float rstd = 1.0f / sqrtf(wave_sum(ss) * (1.0f / 384.0f) + EPS);
              if (lane < 48) { const f32x4 g0 = *(const f32x4*)(qng + lane * 8), g1 = *(const f32x4*)(qng + lane * 8 + 4);
                  u32x4 wv; wv.x = pk2(x[0] * rstd * g0[0], x[1] * rstd * g0[1]); wv.y = pk2(x[2] * rstd * g0[2], x[3] * rstd * g0[3]);
                  wv.z = pk2(x[4] * rstd * g1[0], x[5] * rstd * g1[1]); wv.w = pk2(x[6] * rstd * g1[2], x[7] * rstd * g1[3]); *(u32x4*)(pr + 1536 + lane * 8) = wv; } }
            { float x[8]; u32x4 raw = (u32x4){0u, 0u, 0u, 0u}; if (lane < 32) raw = *(const u32x4*)(pr + 1920 + lane * 8);
              float ss = 0.f;
#pragma unroll
              for (int i = 0; i < 4; ++i) { x[2 * i] = bf2f(raw[i] & 0xffff); x[2 * i + 1] = bf2f(raw[i] >> 16); ss += x[2 * i] * x[2 * i] + x[2 * i + 1] * x[2 * i + 1]; }
              const float rstd = 1.0f / sqrtf(wave_sum(ss) * (1.0f / 256.0f) + EPS);
              if (lane < 32) { const f32x4 g0 = *(const f32x4*)(kvg + lane * 8), g1 = *(const f32x4*)(kvg + lane * 8 + 4);
                  float y[8];
#pragma unroll
                  for (int i = 0; i < 4; ++i) { y[i] = x[i] * rstd * g0[i]; y[4 + i] = x[4 + i] * rstd * g1[i]; }
                  float* fo = OUT + O_LAT + (size_t)row * 256 + lane * 8; __builtin_nontemporal_store((f32x4){y[0], y[1], y[2], y[3]}, (f32x4*)fo); __builtin_nontemporal_store((f32x4){y[4], y[5], y[6], y[7]}, (f32x4*)(fo + 4));
                  const size_t lr = row < NP ? (size_t)row : (size_t)NP + (size_t)((row - NP) >> 4) * LKSP + 1024 + ((row - NP) & 15);
                  u32x4 wv; wv.x = pk2(y[0], y[1]); wv.y = pk2(y[2], y[3]); wv.z = pk2(y[4], y[5]); wv.w = pk2(y[6], y[7]); *(u32x4*)(LAT + lr * 256 + lane * 8) = wv; } }
            { float x[8], y[8]; u32x4 raw = (u32x4){0u, 0u, 0u, 0u}; if (lane < 8) raw = *(const u32x4*)(pr + 2176 + lane * 8);
#pragma unroll
              for (int i = 0; i < 4; ++i) { x[2 * i] = bf2f(raw[i] & 0xffff); x[2 * i + 1] = bf2f(raw[i] >> 16); }
#pragma unroll
              for (int i = 0; i < 8; ++i) { const float o = __shfl_xor(x[i], 4); y[i] = ishi ? (x[i] * cs[i] + o * sn[i]) : (x[i] * cs[i] - o * sn[i]); }
              if (lane < 8) { float* fo = OUT + O_KR + (size_t)row * 64 + lane * 8; __builtin_nontemporal_store((f32x4){y[0], y[1], y[2], y[3]}, (f32x4*)fo); __builtin_nontemporal_store((f32x4){y[4], y[5], y[6], y[7]}, (f32x4*)(fo + 4));
                  const size_t lr = row < NP ? (size_t)row : (size_t)NP + (size_t)((row - NP) >> 4) * LKSP + 1024 + ((row - NP) & 15);
                  u32x4 wv; wv.x = pk2(y[0], y[1]); wv.y = pk2(y[2], y[3]); wv.z = pk2(y[4], y[5]); wv.w = pk2(y[6], y[7]); *(u32x4*)(KR + lr * 64 + lane * 8) = wv; } }
        }
    }
    xcd_barrier(xb);
    {
        small_bf16(lds, BIG + (size_t)NP * PROJ_LD + 1536, PROJ_LD, 384, WUQ, 768, BQ, 768, 0.07216878364870322f * LOG2E, nullptr, nullptr, 0, G, (c + 128) % G);
        { pg8::Gemm gg_{BIG + 1536, WUQ, NP, 768, 384, PROJ_LD}; pg8::StaticOrder so_; so_.init(NP, 768, G, c);
          pg8::EpiBf16<false> e_{BQ, 768, 0.07216878364870322f * LOG2E, nullptr, nullptr, 0}; pg8::gemm_phase(lds, gg_, so_, e_); }
        { pg8::Gemm gg_{LAT, WUKV, MKV, 1024, 256, 256}; pg8::StaticOrder so_; so_.init(MKV, 1024, G, (c + 128) % G);
          pg8::EpiBf16<false> e_{KV, 1024, 1.0f, nullptr, nullptr, 0}; pg8::gemm_phase(lds, gg_, so_, e_); }
    }
    xcd_barrier(xb);
    {
        const float* al = P.in[16];
        const float lam = __expf(wave_sum(al[lane] * al[64 + lane])) - __expf(wave_sum(al[128 + lane] * al[192 + lane])) + LAM_INIT;
        const int xcd = c & 7, jx = c >> 3, bh = xcd * 8 + (jx >> 2), b = bh >> 2, h = bh & 3, a0 = (2 * jx) & 7, pb = jx & 3;
        const size_t rb = (size_t)b * 2048;
        for (int rr = 0; rr < 7; ++rr) {
            if (rr == 6 && c >= 64) continue;
            AU u; u.k2 = nullptr; u.ldk2 = 0; u.h = 0; u.kpos0 = 0; u.nqw = 8; u.kt0 = 0; u.lk = 1 << 30;
            int kind;
            if (rr == 1 || rr == 4) {
                const int p8 = rr == 1 ? pb : 7 - pb; const size_t r0 = rb + 256 * p8; kind = 1;
                u.kt1 = 4 * p8 + 4; u.qpos0 = 256 * p8;
                u.q = BQ + r0 * 768 + h * 192; u.ldq = 768; u.k1 = KV + rb * 1024 + h * 256; u.ldk1 = 1024; u.k2 = KR + rb * 64; u.ldk2 = 64; u.v = KV + rb * 1024 + h * 256 + 128; u.ldv = 1024; u.o = OAB + r0 * DM + 512 + h * 128;
            } else if (rr < 6) {
                const int qi = rr == 0 ? a0 : (rr == 2 ? 15 - a0 : (rr == 3 ? a0 + 1 : 14 - a0)); const size_t r0 = rb + 128 * qi; kind = 0;
                u.kt1 = 2 * qi + 2; u.qpos0 = 128 * qi;
                u.q = BIG + r0 * PROJ_LD + h * 128; u.ldq = PROJ_LD; u.k1 = BIG + rb * PROJ_LD + 512 + h * 128; u.ldk1 = PROJ_LD; u.v = BIG + rb * PROJ_LD + 1024 + h * 128; u.ldv = PROJ_LD; u.o = OAB + r0 * DM + h * 128;
            } else {
                const int si = c, sbh = si & 31, sb = sbh >> 2, sh = sbh & 3; kind = (si >> 5) ? 2 : 0;
                const size_t r0 = (size_t)NP + 16 * sb;
                u.nqw = 1; u.kt1 = 17; u.lk = LKS; u.qpos0 = 1024;
                if (kind == 0) { u.q = BIG + r0 * PROJ_LD + sh * 128; u.ldq = PROJ_LD; u.k1 = KAS + (size_t)sb * LKSP * 512 + sh * 128; u.ldk1 = 512; u.v = VAS + (size_t)sb * LKSP * 512 + sh * 128; u.ldv = 512; u.o = OAB + r0 * DM + sh * 128; }
                else { const size_t kr0 = (size_t)NP + (size_t)sb * LKSP; u.q = BQ + r0 * 768 + sh * 192; u.ldq = 768; u.k1 = KV + kr0 * 1024 + sh * 256; u.ldk1 = 1024; u.k2 = KR + kr0 * 64; u.ldk2 = 64; u.v = KV + kr0 * 1024 + sh * 256 + 128; u.ldv = 1024; u.o = OAB + r0 * DM + 512 + sh * 128; }
            }
            if (kind == 0) attn_unit<0, 1>(lds, u, lam, P.in[17], nullptr);
            else if (kind == 1) attn_unit<1, 2>(lds, u, lam, nullptr, nullptr);
            else attn_unit<1, 1>(lds, u, lam, nullptr, nullptr);
        }
        if (c >= 64) {
            LAS float* scr = (LAS float*)(lds + wave * 8448);
            constexpr int I_FI = 16 * 176, I_FO = 44 * 32, I_SQ = 16 * 32, I_CI = 16 * 96;
            constexpr int NITEMS1 = 2 * I_FI + 2 * I_FO + I_CI + I_SQ;
            for (int it = (c - 64) * 8 + wave; it < NITEMS1; it += 192 * 8) {
                int r = it;
                if (r < 2 * I_FI) { const int mi = 2 + r / I_FI; transpose_item(P.in[13] + (size_t)mi * 1024 * 5632, 1024, 5632, 5632, WFI + (size_t)mi * 5632 * 1024, 1, scr, r % I_FI, lane); continue; } r -= 2 * I_FI;
                if (r < 2 * I_FO) { const int mi = 2 + r / I_FO; transpose_item(P.in[14] + (size_t)mi * 2816 * 1024, 2816, 1024, 1024, WFO + (size_t)mi * 1024 * 2816, 0, scr, r % I_FO, lane); continue; } r -= 2 * I_FO;
                if (r < I_CI) { transpose_item(P.in[23], 1024, 3072, 3072, WCI, 0, scr, r, lane); continue; } r -= I_CI;
                transpose_item(P.in[25], 1024, 1024, 1024, WCO, 0, scr, r, lane);
            }
        }
    }
    xcd_barrier(xb);
    {
        for (int un = gw; un < 896; un += NGW) {
            int r = un;
            if (r < 704) { const int mi = 2 + r / 352, inst = mi == 2 ? 3 : 5; wave_bias(SHB + (size_t)inst * 128 * 1024, WFI + (size_t)mi * 5632 * 1024, 5632, BW + (size_t)mi * 24 * 5632, r % 352, lane); continue; } r -= 704;
            wave_bias(SHB + (size_t)4 * 128 * 1024, WCI, 3072, BWC, r, lane);
        }
        small_resid(lds, OAB + (size_t)NP * DM, 1024, WABO, nullptr, X, MOD + (size_t)5 * 1024, 1.0f, SSQ + 2 * 33024, GS + 2 * 24 * 1024, RGS + 1 * 24 * 1024, H, true, G, c);
        pg8::Gemm gg_{OAB, WABO, NP, 1024, 1024, 1024}; pg8::StaticOrder so_; so_.init(NP, 1024, G, c);
        pg8::EpiResid<true, false> e_{xp, X, MOD + (size_t)5 * 1024, 1.0f, SSQ + 2 * 33024, GS + 2 * 24 * 1024, RGS + 1 * 24 * 1024, H}; pg8::gemm_phase(lds, gg_, so_, e_);
    }
    xcd_barrier(xb);
    FFN_PHASES(0, 1, false, SSQ + 2 * 33024, (BW + 1 * 24 * 5632), SSQ + 3 * 33024, GS + 3 * 24 * 1024, RGS + 2 * 24 * 1024, true);

    FFN_PHASES(1, 0, false, SSQ + 3 * 33024, (BW + 2 * 24 * 5632), SSQ + 4 * 33024, GS + 4 * 24 * 1024, RGS + 3 * 24 * 1024, true);
    {
        small_cqkv(lds, H + (size_t)NP * DM, WCI, BIG, 0.125f * LOG2E, OUT, KCS, VCS, SSQ + 4 * 33024, BWC, G, c);
        pg8::Gemm gg_{H, WCI, NP, 3072, 1024, 1024}; pg8::StaticOrder so_; so_.init(NP, 3072, G, c);
        pg8::EpiCqkv e_{BIG, 0.125f * LOG2E, OUT, SSQ + 4 * 33024, BWC}; pg8::gemm_phase(lds, gg_, so_, e_);
    }
    xcd_barrier(xb);
    {
        LAS float* biasT = (LAS float*)(lds + 65536);
        for (int i = tid; i < 16 * 257; i += 512) biasT[i] = P.in[24][i] * LOG2E;
        __syncthreads();
        const int xcd = c & 7, jx = c >> 3;
        for (int rr = 0; rr < 9; ++rr) {
            if (rr == 8 && c >= 128) continue;
            AU u; u.k2 = nullptr; u.ldk2 = 0;
            if (rr < 8) {
                const int bh = xcd * 32 + 4 * rr + (jx & 3), q8 = ((jx >> 2) + rr) & 7, b = bh >> 4, h = bh & 15;
                const size_t r0 = (size_t)b * 2048 + 256 * q8, rb = (size_t)b * 2048;
                u.q = BIG + r0 * 3072 + h * 64; u.ldq = 3072; u.k1 = BIG + rb * 3072 + 1024 + h * 64; u.ldk1 = 3072; u.v = BIG + rb * 3072 + 2048 + h * 64; u.ldv = 3072; u.o = OC + r0 * DM + h * 64;
                u.nqw = 8; u.kt0 = 4 * q8 - 8 < 0 ? 0 : 4 * q8 - 8; u.kt1 = 4 * q8 + 4; u.lk = 1 << 30; u.qpos0 = 256 * q8; u.kpos0 = 0; u.h = h;
                attn_unit<2, 2>(lds, u, 0.f, nullptr, biasT);
            } else {
                const int bh = c, b = bh >> 4, h = bh & 15;
                const size_t r0 = (size_t)NP + 16 * b;
                u.q = BIG + r0 * 3072 + h * 64; u.ldq = 3072; u.k1 = KCS + (size_t)b * LCSP * 1024 + h * 64; u.ldk1 = 1024; u.v = VCS + (size_t)b * LCSP * 1024 + h * 64; u.ldv = 1024; u.o = OC + r0 * DM + h * 64;
                u.nqw = 1; u.kt0 = 0; u.kt1 = 9; u.lk = LCS; u.qpos0 = 1024; u.kpos0 = 512; u.h = h;
                attn_unit<2, 1>(lds, u, 0.f, nullptr, biasT);
            }
        }
    }
    xcd_barrier(xb);
    {
        small_resid(lds, OC + (size_t)NP * DM, 1024, WCO, nullptr, X, MOD + (size_t)24 * 9216 + (size_t)5 * 1024, 1.0f, SSQ + 5 * 33024, GS + 5 * 24 * 1024, RGS + 4 * 24 * 1024, H, true, G, c);
        pg8::Gemm gg_{OC, WCO, NP, 1024, 1024, 1024}; pg8::StaticOrder so_; so_.init(NP, 1024, G, c);
        pg8::EpiResid<true, false> e_{xp, X, MOD + (size_t)24 * 9216 + (size_t)5 * 1024, 1.0f, SSQ + 5 * 33024, GS + 5 * 24 * 1024, RGS + 4 * 24 * 1024, H}; pg8::gemm_phase(lds, gg_, so_, e_);
    }
    xcd_barrier(xb);
    FFN_PHASES(1, 1, false, SSQ + 5 * 33024, (BW + 3 * 24 * 5632), SSQ + 6 * 33024, GS + 6 * 24 * 1024, RGS + 5 * 24 * 1024, true);
    {
        for (int row = gw; row < MR; row += NGW) {
            float* xr = X + (size_t)row * DM; const bf16_t* hr = H + (size_t)row * DM; const float rstd = 1.0f / sqrtf(SSQ[6 * 33024 + row] * (1.0f / 1024.0f) + EPS);
#pragma unroll
            for (int j = 0; j < 4; ++j) { const u32x2 r_ = *(const u32x2*)(hr + 4 * lane + 256 * j);
                __builtin_nontemporal_store((f32x4){bf2f(r_.x & 0xffff), bf2f(r_.x >> 16), bf2f(r_.y & 0xffff), bf2f(r_.y >> 16)} * rstd, (f32x4*)(xr + 4 * lane + 256 * j)); }
        }
        { const long total = (long)8 * 496 * 256;
          for (long i = gtid; i < total; i += gthreads) { const int cc = (int)(i & 255); const long br = i >> 8; const int j = (int)(br % 496), b = (int)(br / 496);
              const size_t so = ((size_t)b * 512 + j + 16) * 1024 + cc * 4, dof = ((size_t)b * 512 + j) * 1024 + cc * 4;
              *(f32x4*)(OUT + O_CKS + dof) = *(const f32x4*)(P.in[6] + so); *(f32x4*)(OUT + O_CVS + dof) = *(const f32x4*)(P.in[7] + so); } }
    }
}

extern "C" void kernel_launch(void* const* d_in, const int* in_sizes, int n_in, void* d_out, int out_size, void* d_ws, size_t ws_size, hipStream_t stream) {
    static int grid = 0;
    if (grid == 0) {
        if (n_in != 27 || (size_t)out_size != O_END || ws_size < WS_END) { fprintf(stderr, "kernel_launch: unexpected sizes n_in %d out %d ws %zu (need %zu)\n", n_in, out_size, ws_size, (size_t)WS_END); grid = -1; return; }
        int dev = 0, cus = 0, per_cu = 0;
        hipGetDevice(&dev);
        hipDeviceGetAttribute(&cus, hipDeviceAttributeMultiprocessorCount, dev);
        hipFuncSetAttribute((const void*)fwd_kernel, hipFuncAttributeMaxDynamicSharedMemorySize, LDS_BYTES);
        hipOccupancyMaxActiveBlocksPerMultiprocessor(&per_cu, (const void*)fwd_kernel, 512, LDS_BYTES);
        if (per_cu < 1) { fprintf(stderr, "kernel_launch: occupancy query says %d blocks/CU\n", per_cu); per_cu = 1; }
        (void)hipGetLastError();
        grid = cus;
    }
    if (grid < 0) return;
    Params p{};
    for (int i = 0; i < 27; ++i) p.in[i] = (const float*)d_in[i];
    p.out = (float*)d_out; p.ws = (unsigned char*)d_ws;
    hipMemsetAsync((char*)d_ws + OFF_BAR, 0, (size_t)XCD_BAR_WORDS * 4, stream);
    void* args[] = {&p};
    hipError_t e = hipLaunchCooperativeKernel((const void*)fwd_kernel, dim3(grid), dim3(512), args, LDS_BYTES, stream);
    if (e != hipSuccess) fprintf(stderr, "cooperative launch failed: %s (grid %d)\n", hipGetErrorString(e), grid);
}
```

```cpp
#include <hip/hip_runtime.h>
#include <hip/hip_cooperative_groups.h>
#include <cstdio>
#include <cstdint>
namespace cg = cooperative_groups;

#define LAS __attribute__((address_space(3)))
typedef unsigned short bf16_t;
typedef short bf16x8 __attribute__((ext_vector_type(8)));
typedef short s16x4 __attribute__((ext_vector_type(4)));
typedef float f32x4 __attribute__((ext_vector_type(4)));
typedef float f32x2 __attribute__((ext_vector_type(2)));
typedef unsigned u32x4 __attribute__((ext_vector_type(4)));
typedef unsigned u32x2 __attribute__((ext_vector_type(2)));
typedef __bf16 bf16x2_t __attribute__((ext_vector_type(2)));

constexpr int DM = 1024, NP = 32768, NS = 128, MR = NP + NS, MT = 33024;
constexpr int DFF = 2816, NMOD = 9;
constexpr int LKS = 1040, LKSP = 1088;
constexpr int MKV = NP + 8 * LKSP;
constexpr int LCS = 528, LCSP = 576;
constexpr int PROJ_LD = 2304;
constexpr float EPS = 1e-5f;
constexpr float LOG2E = 1.4426950408889634f;
constexpr float LAM_INIT = 0.2f;

constexpr size_t O_Y = 0;
constexpr size_t O_AK = 33685504, O_AV = 50528256, O_LAT = 67371008, O_KR = 75792384;
constexpr size_t O_CKP = 77897728, O_CKS = 86286336, O_CVP = 90480640, O_CVS = 98869248, O_END = 103063552;

constexpr size_t al256(size_t x) { return (x + 255) & ~(size_t)255; }
constexpr size_t OFF_MOD = 0;
constexpr size_t OFF_WFI = al256(OFF_MOD + (size_t)2 * 24 * 9216 * 4);
constexpr size_t OFF_WFO = OFF_WFI + (size_t)4 * 5632 * 1024 * 2;
constexpr size_t OFF_WABI = OFF_WFO + (size_t)4 * 1024 * 2816 * 2;
constexpr size_t OFF_WUQ = OFF_WABI + (size_t)2304 * 1024 * 2;
constexpr size_t OFF_WUKV = OFF_WUQ + (size_t)768 * 384 * 2;
constexpr size_t OFF_WABO = OFF_WUKV + (size_t)1024 * 256 * 2;
constexpr size_t OFF_WCI = OFF_WABO + (size_t)1024 * 1024 * 2;
constexpr size_t OFF_WCO = OFF_WCI + (size_t)3072 * 1024 * 2;
constexpr size_t OFF_H = OFF_WCO + (size_t)1024 * 1024 * 2;
constexpr size_t OFF_BIG = OFF_H + (size_t)MT * 1024 * 2;
constexpr size_t OFF_BQ = OFF_BIG + (size_t)MT * PROJ_LD * 2;
constexpr size_t OFF_KV = OFF_BIG + (size_t)MT * 3072 * 2;
constexpr size_t OFF_LAT = OFF_KV + (size_t)MKV * 1024 * 2;
constexpr size_t OFF_KR = OFF_LAT + (size_t)MKV * 256 * 2;
constexpr size_t OFF_KAS = OFF_KR + (size_t)MKV * 64 * 2;
constexpr size_t OFF_VAS = OFF_KAS + (size_t)8 * LKSP * 512 * 2;
constexpr size_t OFF_KCS = OFF_VAS + (size_t)8 * LKSP * 512 * 2;
constexpr size_t OFF_VCS = OFF_KCS + (size_t)8 * LCSP * 1024 * 2;
constexpr size_t OFF_GS = OFF_VCS + (size_t)8 * LCSP * 1024 * 2;
constexpr size_t OFF_SHB = OFF_GS + (size_t)7 * 24 * 1024 * 4;
constexpr size_t OFF_BW = OFF_SHB + (size_t)6 * 128 * 1024 * 2;
constexpr size_t OFF_SSQ = OFF_BW + (size_t)24 * 27904 * 4;
constexpr size_t OFF_RGS = OFF_SSQ + (size_t)7 * 33024 * 4;
constexpr size_t OFF_BAR = OFF_RGS + (size_t)6 * 24 * 1024 * 4;
constexpr size_t WS_END = OFF_BAR + (size_t)3456 * 4;
static_assert(OFF_BQ + (size_t)MT * 768 * 2 <= OFF_KV, "BQ fits in BIG tail");
static_assert(WS_END <= (size_t)536870912, "workspace fits 512 MiB");

constexpr int LDS_BYTES = 135168;

struct Params { const float* in[27]; float* out; unsigned char* ws; };

__device__ __forceinline__ float bf2f(unsigned h) { return __uint_as_float(h << 16); }
__device__ __forceinline__ unsigned pk2(float lo, float hi) { f32x2 v = {lo, hi}; bf16x2_t b = __builtin_convertvector(v, bf16x2_t); return __builtin_bit_cast(unsigned, b); }
__device__ __forceinline__ float wave_sum(float v) {
#pragma unroll
    for (int o = 1; o < 64; o <<= 1) v += __shfl_xor(v, o);
    return v;
}
__device__ __forceinline__ int row_batch(int row) { return row < NP ? (row >> 11) : 16 + ((row - NP) >> 4); }
__device__ __forceinline__ int row_pos(int row) { return row < NP ? (row & 2047) : 1024 + ((row - NP) & 15); }
__device__ __forceinline__ float silu_f(float g) { return g * __builtin_amdgcn_rcpf(1.0f + __builtin_amdgcn_exp2f(-g * LOG2E)); }

__device__ __forceinline__ float rows_max(float v) {
    auto a = __builtin_amdgcn_permlane16_swap(__float_as_uint(v), __float_as_uint(v), false, false);
    v = fmaxf(__uint_as_float(a[0]), __uint_as_float(a[1]));
    auto b = __builtin_amdgcn_permlane32_swap(__float_as_uint(v), __float_as_uint(v), false, false);
    return fmaxf(__uint_as_float(b[0]), __uint_as_float(b[1]));
}
__device__ __forceinline__ float rows_sum(float v) {
    auto a = __builtin_amdgcn_permlane16_swap(__float_as_uint(v), __float_as_uint(v), false, false);
    v = __uint_as_float(a[0]) + __uint_as_float(a[1]);
    auto b = __builtin_amdgcn_permlane32_swap(__float_as_uint(v), __float_as_uint(v), false, false);
    return __uint_as_float(b[0]) + __uint_as_float(b[1]);
}

namespace pg8 {
constexpr int BM = 256, BK = 64, HALF = 128, HTB = HALF * BK * 2, STAGE_BYTES = 8 * HTB, NXCD = 8, WGM = 8;
__host__ __device__ __forceinline__ int lds_byte(int r, int c) { const int st = (r >> 4) * 2 + (c >> 5), rr = r & 15, cc = c & 31, ob = rr * 64 + cc * 2; return st * 1024 + (ob ^ (((ob >> 9) & 1) << 5)); }
__host__ __device__ __forceinline__ void stage_rc(int b, int& R, int& C) { const int st = b / 1024, sb = b % 1024, swz = sb ^ (((sb >> 9) & 1) << 5); R = (st >> 1) * 16 + swz / 64; C = (st & 1) * 32 + (swz % 64) / 2; }
__host__ __device__ __forceinline__ int perm32(int rho) { const int n = rho >> 4, i = rho & 15; return 8 * (i >> 2) + 4 * n + (i & 3); }
struct Unit { int pm, pn; };
struct Gemm { const bf16_t* A; const bf16_t* Bt; int M, N, K, lda; };
struct StaticOrder {
    int nM, nN, nwg, G, c;
    __device__ void init(int M, int N, int G_, int c_) { nM = M / BM; nN = N / BM; nwg = nM * nN; G = G_; c = c_; }
    __device__ bool next(int i, Unit& u) const {
        const long L = (long)i * G + c; if (L >= nwg) return false;
        int wgid = (int)L; { const int q = nwg / NXCD, r = nwg % NXCD, xcd = wgid % NXCD, off = wgid / NXCD; wgid = (xcd < r ? xcd * (q + 1) : r * (q + 1) + (xcd - r) * q) + off; }
        const int nig = WGM * nN, gid = wgid / nig, fm = gid * WGM, gsz = (nM - fm) < WGM ? (nM - fm) : WGM;
        u.pm = fm + ((wgid % nig) % gsz); u.pn = (wgid % nig) / gsz; return true;
    }
};

template <class Epi>
__device__ __forceinline__ void gemm_phase(LAS unsigned char* lds, const Gemm g, const StaticOrder& S, const Epi& E) {
    int tid_ = threadIdx.x; asm volatile("" : "+v"(tid_));
    const int tid = tid_, wid = __builtin_amdgcn_readfirstlane(tid >> 6), lane = tid & 63, wr = wid >> 2, wc = wid & 3, fr = lane & 15, fq = lane >> 4;
    const int K = g.K, nt = K / BK, lda = g.lda;
    unsigned voffA[2], voffB[2];
#pragma unroll
    for (int i = 0; i < 2; ++i) { int R, C; stage_rc(tid * 16 + i * 8192, R, C); const int Rb = Epi::PERM ? ((R & ~31) + perm32(R & 31)) : R;
        voffA[i] = (unsigned)(R * lda + C) * 2u; voffB[i] = (unsigned)(Rb * K + C) * 2u; }
    const size_t kstep = (size_t)(BK * 2);
    const size_t hstepA = (size_t)HALF * lda * 2, hstepB = (size_t)HALF * K * 2;
    const size_t tstepA = 2 * hstepA, tstepB = 2 * hstepB;
    const unsigned ldsw = (unsigned)wid * 1024u;
    const int aoff = lds_byte(wr * 64 + fr, fq * 8), boff = lds_byte(wc * 32 + fr, fq * 8);
#define PG8_SA(b, h) (((b) * 2 + (h)) * HTB)
#define PG8_SB(b, h) ((4 + (b) * 2 + (h)) * HTB)
#define PG8_STAGE(bufoff, gbase, voff) do { _Pragma("unroll") for (int _i = 0; _i < 2; ++_i) \
        __builtin_amdgcn_global_load_lds((const unsigned*)((const char*)(gbase) + (voff)[_i]), (LAS unsigned*)(lds + (bufoff) + ldsw + _i * 8192), 16, 0, 0); } while (0)
#define PG8_LDA(dst, b, h) do { _Pragma("unroll") for (int m = 0; m < 4; ++m) _Pragma("unroll") for (int k = 0; k < 2; ++k) dst[m][k] = *(const LAS bf16x8*)(lds + PG8_SA(b, h) + aoff + m * 2048 + k * 1024); } while (0)
#define PG8_LDB(dst, b, h) do { _Pragma("unroll") for (int n = 0; n < 2; ++n) _Pragma("unroll") for (int k = 0; k < 2; ++k) dst[n][k] = *(const LAS bf16x8*)(lds + PG8_SB(b, h) + boff + n * 2048 + k * 1024); } while (0)
#define PG8_MMA(ai, bj, At, Bt) do { __builtin_amdgcn_s_setprio(1); _Pragma("unroll") for (int m = 0; m < 4; ++m) _Pragma("unroll") for (int n = 0; n < 2; ++n) _Pragma("unroll") for (int k = 0; k < 2; ++k) \
        acc[ai][bj][m][n] = __builtin_amdgcn_mfma_f32_16x16x32_bf16(Bt[n][k], At[m][k], acc[ai][bj][m][n], 0, 0, 0); __builtin_amdgcn_s_setprio(0); } while (0)
#define PG8_WAIT_V(n) asm volatile("s_waitcnt vmcnt(" #n ")" ::: "memory")
#define PG8_WAIT_L(n) asm volatile("s_waitcnt lgkmcnt(" #n ")" ::: "memory")
#define PG8_BAR __builtin_amdgcn_s_barrier()
#define PG8_SCHED __builtin_amdgcn_sched_barrier(0)
    Unit cur, nxt; int ui = 0;
    if (!S.next(0, cur)) return;
    f32x4 acc[2][2][4][2];
#pragma unroll
    for (int a = 0; a < 2; ++a)
#pragma unroll
        for (int b = 0; b < 2; ++b)
#pragma unroll
            for (int m = 0; m < 4; ++m)
#pragma unroll
                for (int n = 0; n < 2; ++n) acc[a][b][m][n] = (f32x4){0.f, 0.f, 0.f, 0.f};
    bf16x8 At[4][2], B0[2][2], B1[2][2];
    const char* cA = (const char*)g.A + (size_t)cur.pm * tstepA; const char* cB = (const char*)g.Bt + (size_t)cur.pn * tstepB;
    PG8_STAGE(PG8_SB(0, 0), cB, voffB); PG8_STAGE(PG8_SB(0, 1), cB + hstepB, voffB); PG8_STAGE(PG8_SA(0, 0), cA, voffA); PG8_STAGE(PG8_SA(0, 1), cA + hstepA, voffA);
    if (wr == 1) PG8_BAR;
    PG8_WAIT_V(2); PG8_BAR;
    PG8_STAGE(PG8_SB(1, 0), cB + kstep, voffB); PG8_STAGE(PG8_SA(1, 0), cA + kstep, voffA); PG8_STAGE(PG8_SB(1, 1), cB + hstepB + kstep, voffB);
    PG8_WAIT_V(6); PG8_BAR;
    for (;;) {
        const bool has_next = S.next(ui + 1, nxt);
        const char* nA = has_next ? (const char*)g.A + (size_t)nxt.pm * tstepA : cA; const char* nB = has_next ? (const char*)g.Bt + (size_t)nxt.pn * tstepB : cB;
        for (int t = 0; t < nt; t += 2) {
            const bool last = (t == nt - 2);
            const char* a1 = cA + (size_t)(t + 1) * kstep;
            const char* a2 = last ? nA : cA + (size_t)(t + 2) * kstep; const char* b2 = last ? nB : cB + (size_t)(t + 2) * kstep;
            const char* a3 = a2 + kstep; const char* b3 = b2 + kstep;
            PG8_LDB(B0, 0, 0); PG8_LDB(B1, 0, 1); PG8_SCHED; PG8_LDA(At, 0, 0); PG8_STAGE(PG8_SA(1, 1), a1 + hstepA, voffA);
            PG8_WAIT_V(8); PG8_WAIT_L(0); PG8_BAR; PG8_MMA(0, 0, At, B0); PG8_MMA(0, 1, At, B1); PG8_BAR; PG8_SCHED;
            PG8_LDA(At, 0, 1); PG8_STAGE(PG8_SB(0, 0), b2, voffB); PG8_STAGE(PG8_SB(0, 1), b2 + hstepB, voffB); PG8_STAGE(PG8_SA(0, 0), a2, voffA);
            PG8_WAIT_V(8); PG8_WAIT_L(0); PG8_BAR; PG8_MMA(1, 0, At, B0); PG8_MMA(1, 1, At, B1); PG8_BAR; PG8_SCHED;
            PG8_LDB(B0, 1, 0); PG8_LDB(B1, 1, 1); PG8_SCHED; PG8_LDA(At, 1, 0); PG8_STAGE(PG8_SA(0, 1), a2 + hstepA, voffA);
            PG8_WAIT_V(8); PG8_WAIT_L(0); PG8_BAR; PG8_MMA(0, 0, At, B0); PG8_MMA(0, 1, At, B1); PG8_BAR; PG8_SCHED;
            PG8_LDA(At, 1, 1); PG8_STAGE(PG8_SB(1, 0), b3, voffB); PG8_STAGE(PG8_SB(1, 1), b3 + hstepB, voffB); PG8_STAGE(PG8_SA(1, 0), a3, voffA);
            PG8_WAIT_V(8); PG8_WAIT_L(0); PG8_BAR; PG8_MMA(1, 0, At, B0); PG8_MMA(1, 1, At, B1); PG8_BAR; PG8_SCHED;
        }
        if (wr == 0) PG8_BAR;
        E(acc, cur, wr, wc, fr, fq);
        if (!has_next) break;
#pragma unroll
        for (int a = 0; a < 2; ++a)
#pragma unroll
            for (int b = 0; b < 2; ++b)
#pragma unroll
                for (int m = 0; m < 4; ++m)
#pragma unroll
                    for (int n = 0; n < 2; ++n) acc[a][b][m][n] = (f32x4){0.f, 0.f, 0.f, 0.f};
        cur = nxt; cA = nA; cB = nB; ++ui;
        if (wr == 1) PG8_BAR;
    }
    PG8_WAIT_V(0);
    PG8_BAR;
#undef PG8_SA
#undef PG8_SB
#undef PG8_STAGE
#undef PG8_LDA
#undef PG8_LDB
#undef PG8_MMA
#undef PG8_WAIT_V
#undef PG8_WAIT_L
#undef PG8_BAR
#undef PG8_SCHED
}

template <bool HAS_AN, bool FROM_F32>
struct EpiResid {
    static constexpr bool PERM = false;
    const float* xp; float* X; const float* modp; float coef; float* ssq; const float* gs; const float* rgs; bf16_t* An;
    __device__ __forceinline__ void operator()(const f32x4 (&acc)[2][2][4][2], const Unit& u, int wr, int wc, int fr, int fq) const {
        const int b = (u.pm * BM) >> 11; const float cf_ = coef;
        const int colb = u.pn * BM + wc * 32 + fq * 4;
        f32x4 gvv[2][2], gsv[2][2], rgv[2][2];
#pragma unroll
        for (int bj = 0; bj < 2; ++bj)
#pragma unroll
            for (int n = 0; n < 2; ++n) { const f32x4 t_ = *(const f32x4*)(modp + (size_t)b * 9216 + colb + bj * HALF + n * 16); gvv[bj][n] = (f32x4){t_[0] * cf_, t_[1] * cf_, t_[2] * cf_, t_[3] * cf_};
                if (HAS_AN) gsv[bj][n] = *(const f32x4*)(gs + (size_t)b * 1024 + colb + bj * HALF + n * 16);
                if (!FROM_F32) rgv[bj][n] = *(const f32x4*)(rgs + (size_t)b * 1024 + colb + bj * HALF + n * 16); }
        const size_t rowoff = (size_t)(u.pm * BM + wr * 64 + fr) * DM + colb;
        const float* __restrict__ basep = xp + rowoff;
        float* __restrict__ outp = X + rowoff;
        bf16_t* anp = An + rowoff;
        float* ssqp = ssq + u.pm * BM + wr * 64 + fr;
#pragma unroll
        for (int ai = 0; ai < 2; ++ai) {
            f32x4 bsf[FROM_F32 ? 2 : 1][2][2]; u32x2 bsh[FROM_F32 ? 1 : 4][2][2];
            if (!FROM_F32) {
#pragma unroll
                for (int m = 0; m < 4; ++m)
#pragma unroll
                    for (int bj = 0; bj < 2; ++bj)
#pragma unroll
                        for (int n = 0; n < 2; ++n) bsh[m][bj][n] = *(const u32x2*)(anp + (size_t)(ai * HALF + m * 16) * DM + bj * HALF + n * 16);
            }
#pragma unroll
            for (int mp = 0; mp < 2; ++mp) {
                if (FROM_F32) {
#pragma unroll
                    for (int mm = 0; mm < 2; ++mm)
#pragma unroll
                        for (int bj = 0; bj < 2; ++bj)
#pragma unroll
                            for (int n = 0; n < 2; ++n) bsf[mm][bj][n] = *(const f32x4*)(basep + (size_t)(ai * HALF + (2 * mp + mm) * 16) * DM + bj * HALF + n * 16);
                }
#pragma unroll
                for (int mm = 0; mm < 2; ++mm) {
                    const int m = 2 * mp + mm; const size_t ro = (size_t)(ai * HALF + m * 16) * DM; float sq = 0.f;
#pragma unroll
                    for (int bj = 0; bj < 2; ++bj)
#pragma unroll
                        for (int n = 0; n < 2; ++n) {
                            f32x4 xo;
                            if (FROM_F32) xo = bsf[mm][bj][n];
                            else { const u32x2 r_ = bsh[m][bj][n]; xo = (f32x4){bf2f(r_.x & 0xffff), bf2f(r_.x >> 16), bf2f(r_.y & 0xffff), bf2f(r_.y >> 16)} * rgv[bj][n]; }
                            const f32x4 xn = xo + gvv[bj][n] * acc[ai][bj][m][n];
                            sq += xn[0] * xn[0] + xn[1] * xn[1] + xn[2] * xn[2] + xn[3] * xn[3];
                            if (HAS_AN) { const f32x4 hv = xn * gsv[bj][n]; u32x2 o; o.x = pk2(hv[0], hv[1]); o.y = pk2(hv[2], hv[3]); *(u32x2*)(anp + ro + bj * HALF + n * 16) = o; }
                            else *(f32x4*)(outp + ro + bj * HALF + n * 16) = xn; }
                    sq = rows_sum(sq);
                    if (fq == (m & 3)) __hip_atomic_fetch_add(ssqp + ai * HALF + m * 16, sq, __ATOMIC_RELAXED, __HIP_MEMORY_SCOPE_AGENT);
                }
            }
        }
    }
};
struct EpiSwiglu {
    static constexpr bool PERM = true;
    bf16_t* ACT; const float* ssq; const float* biasw;
    __device__ __forceinline__ void operator()(const f32x4 (&acc)[2][2][4][2], const Unit& u, int wr, int wc, int fr, int fq) const {
        const int b = (u.pm * BM) >> 11;
        const float* bw = biasw + (size_t)b * 5632 + u.pn * BM + wc * 32 + 8 * fq;
        const f32x4 bg0 = *(const f32x4*)(bw), bg1 = *(const f32x4*)(bw + 4), bu0 = *(const f32x4*)(bw + 128), bu1 = *(const f32x4*)(bw + 132);
        float rs[2][4];
#pragma unroll
        for (int ai = 0; ai < 2; ++ai)
#pragma unroll
            for (int m = 0; m < 4; ++m) rs[ai][m] = ssq[u.pm * BM + ai * HALF + wr * 64 + m * 16 + fr];
#pragma unroll
        for (int ai = 0; ai < 2; ++ai)
#pragma unroll
            for (int m = 0; m < 4; ++m) {
                const int row = u.pm * BM + ai * HALF + wr * 64 + m * 16 + fr;
                const float rstd = __builtin_amdgcn_rsqf(rs[ai][m] * (1.0f / 1024.0f) + EPS);
                bf16_t* p = ACT + (size_t)row * DFF + u.pn * 128 + wc * 32 + 8 * fq;
                const f32x4 g0 = acc[ai][0][m][0] * rstd + bg0, g1 = acc[ai][0][m][1] * rstd + bg1, u0 = acc[ai][1][m][0] * rstd + bu0, u1 = acc[ai][1][m][1] * rstd + bu1;
                u32x4 w;
                w.x = pk2(silu_f(g0[0]) * u0[0], silu_f(g0[1]) * u0[1]); w.y = pk2(silu_f(g0[2]) * u0[2], silu_f(g0[3]) * u0[3]);
                w.z = pk2(silu_f(g1[0]) * u1[0], silu_f(g1[1]) * u1[1]); w.w = pk2(silu_f(g1[2]) * u1[2], silu_f(g1[3]) * u1[3]);
                *(u32x4*)p = w;
            }
    }
};
template <bool NORM>
struct EpiBf16 {
    static constexpr bool PERM = true;
    bf16_t* O; int ldc; float scale; const float* ssq; const float* biasw; int ldb;
    __device__ __forceinline__ void operator()(const f32x4 (&acc)[2][2][4][2], const Unit& u, int wr, int wc, int fr, int fq) const {
        f32x4 bv[2][2];
        if (NORM) { const int b = (u.pm * BM) >> 11; const float* bw = biasw + (size_t)b * ldb + u.pn * BM + wc * 32 + 8 * fq;
#pragma unroll
            for (int bj = 0; bj < 2; ++bj) { bv[bj][0] = *(const f32x4*)(bw + bj * HALF); bv[bj][1] = *(const f32x4*)(bw + bj * HALF + 4); } }
        float rs[2][4];
        if (NORM) {
#pragma unroll
            for (int ai = 0; ai < 2; ++ai)
#pragma unroll
                for (int m = 0; m < 4; ++m) rs[ai][m] = ssq[u.pm * BM + ai * HALF + wr * 64 + m * 16 + fr];
        }
#pragma unroll
        for (int ai = 0; ai < 2; ++ai)
#pragma unroll
            for (int m = 0; m < 4; ++m) {
                const int row = u.pm * BM + ai * HALF + wr * 64 + m * 16 + fr;
                float rstd = 1.0f; if (NORM) rstd = __builtin_amdgcn_rsqf(rs[ai][m] * (1.0f / 1024.0f) + EPS);
                bf16_t* rowp = O + (size_t)row * ldc + u.pn * BM + wc * 32 + 8 * fq;
#pragma unroll
                for (int bj = 0; bj < 2; ++bj) { f32x4 v0 = acc[ai][bj][m][0], v1 = acc[ai][bj][m][1];
                    if (NORM) { v0 = v0 * rstd + bv[bj][0]; v1 = v1 * rstd + bv[bj][1]; }
                    v0 = v0 * scale; v1 = v1 * scale;
                    u32x4 w; w.x = pk2(v0[0], v0[1]); w.y = pk2(v0[2], v0[3]); w.z = pk2(v1[0], v1[1]); w.w = pk2(v1[2], v1[3]);
                    *(u32x4*)(rowp + bj * HALF) = w; }
            }
    }
};
struct EpiCqkv {
    static constexpr bool PERM = true;
    bf16_t* O; float qscale; float* out; const float* ssq; const float* biasw;
    __device__ __forceinline__ void operator()(const f32x4 (&acc)[2][2][4][2], const Unit& u, int wr, int wc, int fr, int fq) const {
        const int kv = (u.pn >> 2) - 1;
        const float sc = kv < 0 ? qscale : 1.0f;
        const int b = (u.pm * BM) >> 11; const float* bw = biasw + (size_t)b * 3072 + u.pn * BM + wc * 32 + 8 * fq;
        f32x4 bv[2][2];
#pragma unroll
        for (int bj = 0; bj < 2; ++bj) { bv[bj][0] = *(const f32x4*)(bw + bj * HALF); bv[bj][1] = *(const f32x4*)(bw + bj * HALF + 4); }
        float rs[2][4];
#pragma unroll
        for (int ai = 0; ai < 2; ++ai)
#pragma unroll
            for (int m = 0; m < 4; ++m) rs[ai][m] = ssq[u.pm * BM + ai * HALF + wr * 64 + m * 16 + fr];
#pragma unroll
        for (int ai = 0; ai < 2; ++ai)
#pragma unroll
            for (int m = 0; m < 4; ++m) {
                const int row = u.pm * BM + ai * HALF + wr * 64 + m * 16 + fr;
                const float rstd = __builtin_amdgcn_rsqf(rs[ai][m] * (1.0f / 1024.0f) + EPS);
                const int col0 = u.pn * BM + wc * 32 + 8 * fq;
                bf16_t* rowp = O + (size_t)row * 3072 + col0;
                float* fo = nullptr;
                if (kv >= 0) { const int ck = col0 - 1024 * (1 + kv); const int t = row & 2047; if (t >= 1536) fo = out + (kv ? O_CVP : O_CKP) + ((size_t)(row >> 11) * 512 + (t - 1536)) * 1024 + ck; }
#pragma unroll
                for (int bj = 0; bj < 2; ++bj) { const f32x4 v0 = (acc[ai][bj][m][0] * rstd + bv[bj][0]) * sc, v1 = (acc[ai][bj][m][1] * rstd + bv[bj][1]) * sc;
                    u32x4 w; w.x = pk2(v0[0], v0[1]); w.y = pk2(v0[2], v0[3]); w.z = pk2(v1[0], v1[1]); w.w = pk2(v1[2], v1[3]);
                    *(u32x4*)(rowp + bj * HALF) = w;
                    if (fo) { __builtin_nontemporal_store(v0, (f32x4*)(fo + bj * HALF)); __builtin_nontemporal_store(v1, (f32x4*)(fo + bj * HALF + 4)); } }
            }
    }
};
}


template <int NB>
__device__ __forceinline__ void small_core(LAS unsigned char* lds, const bf16_t* A, int lda, const bf16_t* B0, const bf16_t* B1, int K, f32x4 (&out)[NB]) {
    int tid_ = threadIdx.x; asm volatile("" : "+v"(tid_));
    const int tid = tid_, lane = tid & 63, w = __builtin_amdgcn_readfirstlane(tid >> 6), fr = lane & 15, fq = lane >> 4;
    f32x4 acc[NB][8];
#pragma unroll
    for (int nb = 0; nb < NB; ++nb)
#pragma unroll
        for (int mb = 0; mb < 8; ++mb) acc[nb][mb] = (f32x4){0.f, 0.f, 0.f, 0.f};
    const bf16_t* ap = A + (size_t)fr * lda + 8 * fq;
    const bf16_t* bp0 = B0 + (size_t)fr * K + 8 * fq;
    const bf16_t* bp1 = B1 + (size_t)fr * K + 8 * fq;
    const int nsteps = K >> 5;
    int st = w;
    for (; st + 8 < nsteps; st += 16) {
        const int k = st * 32, k2 = k + 256;
        bf16x8 b[NB], b2[NB]; b[0] = *(const bf16x8*)(bp0 + k); b2[0] = *(const bf16x8*)(bp0 + k2);
        if (NB == 2) { b[NB - 1] = *(const bf16x8*)(bp1 + k); b2[NB - 1] = *(const bf16x8*)(bp1 + k2); }
        bf16x8 a[8], a2[8];
#pragma unroll
        for (int mb = 0; mb < 8; ++mb) { a[mb] = *(const bf16x8*)(ap + (size_t)(16 * mb) * lda + k); a2[mb] = *(const bf16x8*)(ap + (size_t)(16 * mb) * lda + k2); }
#pragma unroll
        for (int mb = 0; mb < 8; ++mb)
#pragma unroll
            for (int nb = 0; nb < NB; ++nb) { acc[nb][mb] = __builtin_amdgcn_mfma_f32_16x16x32_bf16(b[nb], a[mb], acc[nb][mb], 0, 0, 0);
                acc[nb][mb] = __builtin_amdgcn_mfma_f32_16x16x32_bf16(b2[nb], a2[mb], acc[nb][mb], 0, 0, 0); }
    }
    if (st < nsteps) {
        const int k = st * 32;
        bf16x8 b[NB]; b[0] = *(const bf16x8*)(bp0 + k); if (NB == 2) b[NB - 1] = *(const bf16x8*)(bp1 + k);
        bf16x8 a[8];
#pragma unroll
        for (int mb = 0; mb < 8; ++mb) a[mb] = *(const bf16x8*)(ap + (size_t)(16 * mb) * lda + k);
#pragma unroll
        for (int mb = 0; mb < 8; ++mb)
#pragma unroll
            for (int nb = 0; nb < NB; ++nb) acc[nb][mb] = __builtin_amdgcn_mfma_f32_16x16x32_bf16(b[nb], a[mb], acc[nb][mb], 0, 0, 0);
    }
    LAS float* red = (LAS float*)lds;
    __syncthreads();
#pragma unroll
    for (int nb = 0; nb < NB; ++nb)
#pragma unroll
        for (int mb = 0; mb < 8; ++mb) *(LAS f32x4*)(red + ((w * 128 + 16 * mb + fr) * (16 * NB) + nb * 16 + 4 * fq)) = acc[nb][mb];
    __syncthreads();
    const int row = tid >> 2, c4 = (tid & 3) * 4;
#pragma unroll
    for (int nb = 0; nb < NB; ++nb) { f32x4 s = (f32x4){0.f, 0.f, 0.f, 0.f};
#pragma unroll
        for (int w8 = 0; w8 < 8; ++w8) s += *(const LAS f32x4*)(red + ((w8 * 128 + row) * (16 * NB) + nb * 16 + c4));
        out[nb] = s; }
    __syncthreads();
}
__device__ __forceinline__ void small_swiglu(LAS unsigned char* lds, const bf16_t* A, const bf16_t* Bt, bf16_t* ACT, const float* ssq, const float* biasw, int G, int c) {
    for (int un = c; un < DFF / 16; un += G) {
        const int j0 = 16 * un, rg = (j0 >> 7) * 256 + (j0 & 127);
        f32x4 o[2]; small_core<2>(lds, A, 1024, Bt + (size_t)rg * 1024, Bt + (size_t)(rg + 128) * 1024, 1024, o);
        const int row = threadIdx.x >> 2, c4 = (threadIdx.x & 3) * 4, b = 16 + (row >> 4);
        const float rstd = __builtin_amdgcn_rsqf(ssq[NP + row] * (1.0f / 1024.0f) + EPS);
        const f32x4 g = o[0] * rstd + *(const f32x4*)(biasw + (size_t)b * 5632 + rg + c4), uu = o[1] * rstd + *(const f32x4*)(biasw + (size_t)b * 5632 + rg + 128 + c4);
        u32x2 wv; wv.x = pk2(silu_f(g[0]) * uu[0], silu_f(g[1]) * uu[1]); wv.y = pk2(silu_f(g[2]) * uu[2], silu_f(g[3]) * uu[3]);
        *(u32x2*)(ACT + (size_t)(NP + row) * DFF + j0 + c4) = wv;
    }
}
__device__ __forceinline__ void small_resid(LAS unsigned char* lds, const bf16_t* A, int K, const bf16_t* Bt, const float* xs_in, float* X, const float* modp, float coef,
                                            float* ssq, const float* gs, const float* rgs, bf16_t* An, bool has_an, int G, int c) {
    for (int un = c; un < 64; un += G) {
        f32x4 o[1]; small_core<1>(lds, A, K, Bt + (size_t)(16 * un) * K, Bt, K, o);
        const int row = threadIdx.x >> 2, col = 16 * un + (threadIdx.x & 3) * 4, b = 16 + (row >> 4);
        f32x4 bs;
        if (xs_in) bs = *(const f32x4*)(xs_in + (size_t)row * DM + col);
        else { const u32x2 r_ = *(const u32x2*)(An + (size_t)(NP + row) * DM + col); const f32x4 rg = *(const f32x4*)(rgs + (size_t)b * 1024 + col);
               bs = (f32x4){bf2f(r_.x & 0xffff), bf2f(r_.x >> 16), bf2f(r_.y & 0xffff), bf2f(r_.y >> 16)} * rg; }
        const f32x4 gv = *(const f32x4*)(modp + (size_t)b * 9216 + col);
        const f32x4 xn = bs + (gv * coef) * o[0];
        float sq = xn[0] * xn[0] + xn[1] * xn[1] + xn[2] * xn[2] + xn[3] * xn[3];
        if (has_an) { const f32x4 hv = xn * *(const f32x4*)(gs + (size_t)b * 1024 + col); u32x2 wv; wv.x = pk2(hv[0], hv[1]); wv.y = pk2(hv[2], hv[3]); *(u32x2*)(An + (size_t)(NP + row) * DM + col) = wv; }
        else *(f32x4*)(X + (size_t)(NP + row) * DM + col) = xn;
        sq += __shfl_xor(sq, 1); sq += __shfl_xor(sq, 2);
        if ((threadIdx.x & 3) == 0) __hip_atomic_fetch_add(ssq + NP + row, sq, __ATOMIC_RELAXED, __HIP_MEMORY_SCOPE_AGENT);
    }
}
__device__ __forceinline__ void small_bf16(LAS unsigned char* lds, const bf16_t* A, int lda, int K, const bf16_t* Bt, int N, bf16_t* O, int ldc, float scale,
                                           const float* ssq, const float* biasw, int ldb, int G, int c) {
    for (int un = c; un < N / 16; un += G) {
        f32x4 o[1]; small_core<1>(lds, A, lda, Bt + (size_t)(16 * un) * K, Bt, K, o);
        const int row = threadIdx.x >> 2, col = 16 * un + (threadIdx.x & 3) * 4, b = 16 + (row >> 4);
        f32x4 v = o[0];
        if (ssq) v = v * __builtin_amdgcn_rsqf(ssq[NP + row] * (1.0f / 1024.0f) + EPS) + *(const f32x4*)(biasw + (size_t)b * ldb + col);
        v = v * scale; u32x2 wv; wv.x = pk2(v[0], v[1]); wv.y = pk2(v[2], v[3]);
        *(u32x2*)(O + (size_t)(NP + row) * ldc + col) = wv;
    }
}
__device__ __forceinline__ void small_cqkv(LAS unsigned char* lds, const bf16_t* A, const bf16_t* Bt, bf16_t* O, float qscale, float* out, bf16_t* KCS, bf16_t* VCS,
                                           const float* ssq, const float* biasw, int G, int c) {
    for (int un = c; un < 3072 / 16; un += G) {
        f32x4 o[1]; small_core<1>(lds, A, 1024, Bt + (size_t)(16 * un) * 1024, Bt, 1024, o);
        const int row = threadIdx.x >> 2, col = 16 * un + (threadIdx.x & 3) * 4, kv = (col >> 10) - 1, b = 16 + (row >> 4);
        const f32x4 v = (o[0] * __builtin_amdgcn_rsqf(ssq[NP + row] * (1.0f / 1024.0f) + EPS) + *(const f32x4*)(biasw + (size_t)b * 3072 + col)) * (kv < 0 ? qscale : 1.0f);
        u32x2 wv; wv.x = pk2(v[0], v[1]); wv.y = pk2(v[2], v[3]);
        *(u32x2*)(O + (size_t)(NP + row) * 3072 + col) = wv;
        if (kv >= 0) { const int ck = col - 1024 * (1 + kv), bs = row >> 4, t = row & 15;
            *(f32x4*)(out + (kv ? O_CVS : O_CKS) + ((size_t)bs * 512 + 496 + t) * 1024 + ck) = v;
            *(u32x2*)((kv ? VCS : KCS) + ((size_t)bs * LCSP + 512 + t) * 1024 + ck) = wv; }
    }
}
__device__ __forceinline__ void wave_bias(const bf16_t* A, const bf16_t* Bt, int N, float* BW, int unit, int lane) {
    const int fr = lane & 15, fq = lane >> 4;
    f32x4 a0 = (f32x4){0.f, 0.f, 0.f, 0.f}, a1 = a0;
    const bf16_t* ap = A + (size_t)fr * 1024 + 8 * fq; const bf16_t* bp = Bt + (size_t)(16 * unit + fr) * 1024 + 8 * fq;
#pragma unroll 8
    for (int k = 0; k < 1024; k += 32) { const bf16x8 bv = *(const bf16x8*)(bp + k), x0 = *(const bf16x8*)(ap + k), x1 = *(const bf16x8*)(ap + 16 * 1024 + k);
        a0 = __builtin_amdgcn_mfma_f32_16x16x32_bf16(bv, x0, a0, 0, 0, 0); a1 = __builtin_amdgcn_mfma_f32_16x16x32_bf16(bv, x1, a1, 0, 0, 0); }
    *(f32x4*)(BW + (size_t)fr * N + 16 * unit + 4 * fq) = a0;
    if (fr < 8) *(f32x4*)(BW + (size_t)(16 + fr) * N + 16 * unit + 4 * fq) = a1;
}

__device__ __forceinline__ void small_bias(LAS unsigned char* lds, const bf16_t* A, const bf16_t* Bt, int N, float* BW, int G, int c) {
    for (int un = c; un < N / 16; un += G) {
        f32x4 o[1]; small_core<1>(lds, A, 1024, Bt + (size_t)(16 * un) * 1024, Bt, 1024, o);
        const int row = threadIdx.x >> 2, col = 16 * un + (threadIdx.x & 3) * 4;
        if (row < 24) *(f32x4*)(BW + (size_t)row * N + col) = o[0];
    }
}

struct AU { const bf16_t* q; const bf16_t* k1; const bf16_t* k2; const bf16_t* v; bf16_t* o; int ldq, ldk1, ldk2, ldv; int nqw, kt0, kt1, lk, qpos0, kpos0, h; };

template <int MODE, int QB>
__device__ __forceinline__ void attn_unit(LAS unsigned char* lds, const AU& u, float lam, const float* subln_g, const LAS float* biasT) {
    constexpr int NSUB = MODE == 0 ? 2 : 1, DK1 = MODE == 2 ? 64 : 128, DK2 = MODE == 1 ? 64 : 0, DV = MODE == 2 ? 64 : 128;
    constexpr int DKT = DK1 + DK2, DQK = DKT / NSUB, KSTRB = (DKT + 8) * 2, VSTRB = DV * 2 + 32;
    constexpr int NKK = DQK / 32, NDB = DV / 16, BAND = MODE == 2 ? 8 : (1 << 20);
    constexpr int C1 = DK1 / 8, N1 = 64 * C1 / 512, CV = DV / 8, NV = 64 * CV / 512;
    constexpr int BUFB = 64 * KSTRB + 64 * VSTRB;
    constexpr int RW = 16 * QB;
    const int tid = threadIdx.x, lane = tid & 63, w = __builtin_amdgcn_readfirstlane(tid >> 6), r = lane & 15, g = lane >> 4;
    const bool active = w < u.nqw;
    const int qpos = u.qpos0 + RW * w + r;
    bf16x8 qf[QB][NSUB][NKK];
    if (active) {
#pragma unroll
        for (int j = 0; j < QB; ++j) {
            const bf16_t* qp = u.q + (size_t)(RW * w + 16 * j + r) * u.ldq;
#pragma unroll
            for (int s = 0; s < NSUB; ++s)
#pragma unroll
                for (int kk = 0; kk < NKK; ++kk) qf[j][s][kk] = *(const bf16x8*)(qp + s * DQK + 32 * kk + 8 * g);
            if (MODE == 1) {
#pragma unroll
                for (int i = 0; i < 8; ++i) {
                    const int d = 8 * g + i; const float inv = __builtin_amdgcn_exp2f(-(float)d * (13.287712379549449f / 32.0f));
                    const float ang_ = (float)(qpos + 16 * j) * inv; const float sn = __sinf(ang_), cs = __cosf(ang_);
                    const float x1 = bf2f((unsigned short)qf[j][0][NKK - 2][i]), x2 = bf2f((unsigned short)qf[j][0][NKK - 1][i]);
                    const unsigned pr = pk2(x1 * cs - x2 * sn, x2 * cs + x1 * sn);
                    qf[j][0][NKK - 2][i] = (short)(pr & 0xffff); qf[j][0][NKK - 1][i] = (short)(pr >> 16);
                }
            }
        }
    } else {
#pragma unroll
        for (int j = 0; j < QB; ++j)
#pragma unroll
            for (int s = 0; s < NSUB; ++s)
#pragma unroll
                for (int kk = 0; kk < NKK; ++kk) qf[j][s][kk] = (bf16x8){0, 0, 0, 0, 0, 0, 0, 0};
    }
    float mrun[QB][NSUB], lrun[QB][NSUB]; f32x4 O[QB][NSUB][NDB];
#pragma unroll
    for (int j = 0; j < QB; ++j)
#pragma unroll
        for (int s = 0; s < NSUB; ++s) { mrun[j][s] = -INFINITY; lrun[j][s] = 0.f;
#pragma unroll
            for (int db = 0; db < NDB; ++db) O[j][s][db] = (f32x4){0.f, 0.f, 0.f, 0.f}; }
    const int cw = (u.qpos0 + RW * w) >> 6, ck0 = u.kpos0 >> 6;
    u32x4 rk1[N1], rv[NV], rk2;
    const int li = lane & 15, tq = li >> 2, tp = li & 3;
#define ATT_LOAD(kt) do { \
        _Pragma("unroll") for (int i = 0; i < N1; ++i) { const int c = tid + 512 * i, row = c / C1, cc = c % C1; rk1[i] = *(const u32x4*)(u.k1 + (size_t)(64 * (kt) + row) * u.ldk1 + cc * 8); } \
        if (MODE == 1) { const int row = tid >> 3, cc = tid & 7; rk2 = *(const u32x4*)(u.k2 + (size_t)(64 * (kt) + row) * u.ldk2 + cc * 8); } \
        _Pragma("unroll") for (int i = 0; i < NV; ++i) { const int c = tid + 512 * i, row = c / CV, cc = c % CV; rv[i] = *(const u32x4*)(u.v + (size_t)(64 * (kt) + row) * u.ldv + cc * 8); } } while (0)
#define ATT_STORE(bb) do { LAS unsigned char* Ks = lds + (bb) * BUFB; LAS unsigned char* Vs = Ks + 64 * KSTRB; \
        _Pragma("unroll") for (int i = 0; i < N1; ++i) { const int c = tid + 512 * i, row = c / C1, cc = c % C1; *(LAS u32x4*)(Ks + row * KSTRB + cc * 16) = rk1[i]; } \
        if (MODE == 1) { const int row = tid >> 3, cc = tid & 7; *(LAS u32x4*)(Ks + row * KSTRB + DK1 * 2 + cc * 16) = rk2; } \
        _Pragma("unroll") for (int i = 0; i < NV; ++i) { const int c = tid + 512 * i, row = c / CV, cc = c % CV; *(LAS u32x4*)(Vs + row * VSTRB + cc * 16) = rv[i]; } } while (0)
    ATT_LOAD(u.kt0);
    ATT_STORE(0);
    if (u.kt0 + 1 < u.kt1) ATT_LOAD(u.kt0 + 1);
    asm volatile("s_waitcnt lgkmcnt(0)\n\ts_barrier" ::: "memory");
    for (int kt = u.kt0; kt < u.kt1; ++kt) {
        const int cur = (kt - u.kt0) & 1;
        if (kt + 1 < u.kt1) { ATT_STORE(cur ^ 1); if (kt + 2 < u.kt1) ATT_LOAD(kt + 2); }
        const LAS unsigned char* Ks = lds + cur * BUFB; const LAS unsigned char* Vs = Ks + 64 * KSTRB;
        const int ck = ck0 + kt;
        if (active && ck <= cw && ck >= cw - BAND) {
            f32x4 S[QB][NSUB][4];
#pragma unroll
            for (int s = 0; s < NSUB; ++s)
#pragma unroll
                for (int kb = 0; kb < 4; ++kb) {
#pragma unroll
                    for (int j = 0; j < QB; ++j) S[j][s][kb] = (f32x4){0.f, 0.f, 0.f, 0.f};
#pragma unroll
                    for (int kk = 0; kk < NKK; ++kk) { const bf16x8 kf = *(const LAS bf16x8*)(Ks + (16 * kb + r) * KSTRB + (s * DQK + 32 * kk + 8 * g) * 2);
#pragma unroll
                        for (int j = 0; j < QB; ++j) S[j][s][kb] = __builtin_amdgcn_mfma_f32_16x16x32_bf16(kf, qf[j][s][kk], S[j][s][kb], 0, 0, 0); } }
            if (MODE == 2) {
                if (u.kpos0 + 64 * kt + 63 - (u.qpos0 + RW * w) <= -128) {
                    const float bc = biasT[u.h * 257];
#pragma unroll
                    for (int j = 0; j < QB; ++j)
#pragma unroll
                        for (int kb = 0; kb < 4; ++kb) S[j][0][kb] += bc;
                } else {
#pragma unroll
                    for (int j = 0; j < QB; ++j) {
                        const int kp0 = u.kpos0 + 64 * kt + 4 * g - (qpos + 16 * j);
#pragma unroll
                        for (int kb = 0; kb < 4; ++kb)
#pragma unroll
                            for (int e = 0; e < 4; ++e) { int d = kp0 + 16 * kb + e; d = d < -128 ? -128 : (d > 128 ? 128 : d); S[j][0][kb][e] += biasT[u.h * 257 + d + 128]; }
                    }
                }
            }
            if (__builtin_expect((kt + 1) * 64 > u.lk, 0)) {
                asm volatile("" ::: "memory");
#pragma unroll
                for (int j = 0; j < QB; ++j)
#pragma unroll
                    for (int s = 0; s < NSUB; ++s)
#pragma unroll
                        for (int kb = 0; kb < 4; ++kb)
#pragma unroll
                            for (int e = 0; e < 4; ++e) if (64 * kt + 16 * kb + 4 * g + e >= u.lk) S[j][s][kb][e] = -INFINITY;
            }
            bf16x8 pf[QB][NSUB][2];
#pragma unroll
            for (int j = 0; j < QB; ++j)
#pragma unroll
                for (int s = 0; s < NSUB; ++s) {
                    float mx = fmaxf(fmaxf(S[j][s][0][0], S[j][s][0][1]), fmaxf(S[j][s][0][2], S[j][s][0][3]));
#pragma unroll
                    for (int kb = 1; kb < 4; ++kb) mx = fmaxf(mx, fmaxf(fmaxf(S[j][s][kb][0], S[j][s][kb][1]), fmaxf(S[j][s][kb][2], S[j][s][kb][3])));
                    mx = rows_max(mx);
                    const float mn = fmaxf(mrun[j][s], mx), alpha = __builtin_amdgcn_exp2f(mrun[j][s] - mn); mrun[j][s] = mn;
                    float ps = 0.f;
#pragma unroll
                    for (int kb = 0; kb < 4; ++kb)
#pragma unroll
                        for (int e = 0; e < 4; ++e) { const float pe = __builtin_amdgcn_exp2f(S[j][s][kb][e] - mn); S[j][s][kb][e] = pe; ps += pe; }
                    if (__builtin_amdgcn_ballot_w64(alpha != 1.0f) != 0ull) { lrun[j][s] *= alpha;
#pragma unroll
                        for (int db = 0; db < NDB; ++db) O[j][s][db] *= alpha; }
                    lrun[j][s] += ps;
#pragma unroll
                    for (int kc = 0; kc < 2; ++kc) { u32x4 pw; pw.x = pk2(S[j][s][2 * kc][0], S[j][s][2 * kc][1]); pw.y = pk2(S[j][s][2 * kc][2], S[j][s][2 * kc][3]);
                        pw.z = pk2(S[j][s][2 * kc + 1][0], S[j][s][2 * kc + 1][1]); pw.w = pk2(S[j][s][2 * kc + 1][2], S[j][s][2 * kc + 1][3]); pf[j][s][kc] = __builtin_bit_cast(bf16x8, pw); }
                }
#pragma unroll
            for (int db = 0; db < NDB; ++db) {
                bf16x8 vf[2];
#pragma unroll
                for (int kc = 0; kc < 2; ++kc) {
                    const LAS unsigned char* vp = Vs + (32 * kc + 4 * g + tq) * VSTRB + (16 * db + 4 * tp) * 2;
                    const s16x4 lo = __builtin_bit_cast(s16x4, __builtin_amdgcn_ds_read_tr16_b64_v4i16((LAS s16x4*)vp));
                    const s16x4 hi = __builtin_bit_cast(s16x4, __builtin_amdgcn_ds_read_tr16_b64_v4i16((LAS s16x4*)(vp + 16 * VSTRB)));
                    vf[kc] = (bf16x8){lo[0], lo[1], lo[2], lo[3], hi[0], hi[1], hi[2], hi[3]};
                }
#pragma unroll
                for (int j = 0; j < QB; ++j)
#pragma unroll
                    for (int s = 0; s < NSUB; ++s)
#pragma unroll
                        for (int kc = 0; kc < 2; ++kc) O[j][s][db] = __builtin_amdgcn_mfma_f32_16x16x32_bf16(vf[kc], pf[j][s][kc], O[j][s][db], 0, 0, 0);
            }
        }
        asm volatile("s_waitcnt lgkmcnt(0)\n\ts_barrier" ::: "memory");
    }
#undef ATT_LOAD
#undef ATT_STORE
    if (active) {
#pragma unroll
        for (int j = 0; j < QB; ++j) {
            float li_[NSUB];
#pragma unroll
            for (int s = 0; s < NSUB; ++s) { const float l = rows_sum(lrun[j][s]); li_[s] = 1.0f / l; }
            bf16_t* op = u.o + (size_t)(RW * w + 16 * j + r) * DM + 4 * g;
            if (MODE == 0) {
                float ss = 0.f;
#pragma unroll
                for (int db = 0; db < NDB; ++db) { O[j][0][db] = O[j][0][db] * li_[0] - (O[j][NSUB - 1][db] * li_[NSUB - 1]) * lam;
                    ss += O[j][0][db][0] * O[j][0][db][0] + O[j][0][db][1] * O[j][0][db][1] + O[j][0][db][2] * O[j][0][db][2] + O[j][0][db][3] * O[j][0][db][3]; }
                ss = rows_sum(ss);
                const float rstd = 1.0f / sqrtf(ss * (1.0f / 128.0f) + EPS) * (1.0f - LAM_INIT);
#pragma unroll
                for (int db = 0; db < NDB; ++db) { const f32x4 gg = *(const f32x4*)(subln_g + 16 * db + 4 * g); const f32x4 v = O[j][0][db] * rstd * gg;
                    u32x2 wv; wv.x = pk2(v[0], v[1]); wv.y = pk2(v[2], v[3]); *(u32x2*)(op + 16 * db) = wv; }
            } else {
#pragma unroll
                for (int db = 0; db < NDB; ++db) { const f32x4 v = O[j][0][db] * li_[0]; u32x2 wv; wv.x = pk2(v[0], v[1]); wv.y = pk2(v[2], v[3]); *(u32x2*)(op + 16 * db) = wv; }
            }
        }
    }
}

__device__ __forceinline__ void transpose_item(const float* W, int K, int Nsrc, int Nd, bf16_t* WT, int mode, LAS float* scr, int item, int lane) {
    const int nblk = Nd / 32, kb = item / nblk, nb = item % nblk, k0 = 64 * kb, n0 = 32 * nb;
    int sc0 = n0; bool zero = false;
    if (mode == 1) { const int pn = n0 >> 8, bj = (n0 >> 7) & 1, i0 = n0 & 127; sc0 = bj * DFF + 128 * pn + i0; }
    else zero = (n0 >= Nsrc);
    float v_[32];
    const float* wp_ = W + (size_t)(k0 + (lane >> 5)) * Nsrc + sc0 + (lane & 31);
#pragma unroll
    for (int i = 0; i < 32; ++i) v_[i] = zero ? 0.f : wp_[(size_t)(2 * i) * Nsrc];
#pragma unroll
    for (int i = 0; i < 32; ++i) scr[(2 * i + (lane >> 5)) * 33 + (lane & 31)] = v_[i];
    asm volatile("s_waitcnt lgkmcnt(0)" ::: "memory");
    const int c = lane & 7;
#pragma unroll
    for (int j = 0; j < 4; ++j) { const int n = (lane >> 3) + 8 * j; const LAS float* s = scr + (8 * c) * 33 + n;
        u32x4 o; o.x = pk2(s[0 * 33], s[1 * 33]); o.y = pk2(s[2 * 33], s[3 * 33]); o.z = pk2(s[4 * 33], s[5 * 33]); o.w = pk2(s[6 * 33], s[7 * 33]);
        __builtin_nontemporal_store(o, (u32x4*)(WT + (size_t)(n0 + n) * K + k0 + 8 * c)); }
    asm volatile("s_waitcnt lgkmcnt(0)" ::: "memory");
}
__device__ __forceinline__ void conv_rows(const float* src, bf16_t* dst, int B, int R, int C, int dstB, int dstOff, int gtid, int gthreads) {
    const int c4 = C / 4; const long total = (long)B * R * c4;
    for (long i = gtid; i < total; i += gthreads) { const int cc = (int)(i % c4); const long br = i / c4; const int rr = (int)(br % R), b = (int)(br / R);
        const f32x4 v = *(const f32x4*)(src + ((size_t)br * C + cc * 4)); u32x2 o; o.x = pk2(v[0], v[1]); o.y = pk2(v[2], v[3]);
        __builtin_nontemporal_store(o, (u32x2*)(dst + ((size_t)(b * dstB + dstOff + rr) * C + cc * 4))); }
}
__device__ __forceinline__ void zero_rows(bf16_t* dst, int B, int R, int C, int dstB, int dstOff, int gtid, int gthreads) {
    const int c4 = C / 4; const long total = (long)B * R * c4;
    for (long i = gtid; i < total; i += gthreads) { const int cc = (int)(i % c4); const long br = i / c4; const int rr = (int)(br % R), b = (int)(br / R);
        *(u32x2*)(dst + ((size_t)(b * dstB + dstOff + rr) * C + cc * 4)) = (u32x2){0u, 0u}; }
}


#define XB_TMO      128
#define XB_XCNT(j)  (256  + 64 * (j))
#define XB_XSUB(j)  (1280 + 64 * (j))
#define XB_XGEN(j)  (2304 + 64 * (j))
#define XB_TOP      3328
#define XB_TOPGEN   3392
#define XCD_BAR_WORDS 3456
#define XB_SPIN_CAP (1u << 18)
__device__ __forceinline__ unsigned xb_ld(unsigned* p)              { return __hip_atomic_load(p, __ATOMIC_RELAXED, __HIP_MEMORY_SCOPE_AGENT); }
__device__ __forceinline__ unsigned xb_add(unsigned* p, unsigned v) { return __hip_atomic_fetch_add(p, v, __ATOMIC_RELAXED, __HIP_MEMORY_SCOPE_AGENT); }
__device__ __forceinline__ unsigned xb_xcc_id() { return (unsigned)__builtin_amdgcn_s_getreg((3 << 11) | 20) & 0xFu; }
#define XB_SPIN(cond, bar) do { unsigned _sp = 0; while (cond) { __builtin_amdgcn_s_sleep(1); \
    if ((++_sp & 255u) == 0u) { if (xb_ld(&(bar)[XB_TMO])) break; if (_sp > XB_SPIN_CAP) { atomicAdd(&(bar)[XB_TMO], 1u); break; } } } } while (0)
struct XcdBarrier { unsigned* bar; unsigned x; volatile LAS unsigned* st; };
__device__ __forceinline__ XcdBarrier xcd_barrier_post(unsigned* bar, volatile LAS unsigned* st) {
    XcdBarrier b; b.bar = bar; b.x = xb_xcc_id(); b.st = st;
    if (threadIdx.x == 0) (void)xb_add(&bar[XB_XCNT(b.x)], 1u);
    return b;
}
__device__ __forceinline__ void xcd_barrier_complete(unsigned* bar, unsigned x, unsigned& nloc, unsigned& nx) {
    const unsigned G = gridDim.x * gridDim.y * gridDim.z;
    unsigned sum, cnt, mine, sp = 0u;
    for (;;) {
        sum = 0u; cnt = 0u; mine = 0u;
#pragma unroll
        for (unsigned j = 0; j < 16; ++j) { const unsigned c = xb_ld(&bar[XB_XCNT(j)]); sum += c; cnt += (c > 0u) ? 1u : 0u; mine = (j == x) ? c : mine; }
        if (sum == G) break;
        __builtin_amdgcn_s_sleep(1);
        if ((++sp & 255u) == 0u) { if (xb_ld(&bar[XB_TMO])) break; if (sp > XB_SPIN_CAP) { atomicAdd(&bar[XB_TMO], 1u); break; } }
    }
    nloc = mine > 0u ? mine : 1u; nx = cnt > 0u ? cnt : 1u;
}
__device__ __forceinline__ void xcd_barrier(const XcdBarrier& b) {
    asm volatile("s_waitcnt vmcnt(0)" ::: "memory");
    __syncthreads();
    if (threadIdx.x == 0) {
        unsigned* bar = b.bar;
        __builtin_amdgcn_s_waitcnt(0);
        unsigned nloc = b.st[0], nx = b.st[1];
        if (nloc == 0u) { xcd_barrier_complete(bar, b.x, nloc, nx); b.st[0] = nloc; b.st[1] = nx; }
        const unsigned old = xb_add(&bar[XB_XSUB(b.x)], 1u);
        const unsigned gen = old / nloc;
        if (old + 1u == (gen + 1u) * nloc) {
            __builtin_amdgcn_fence(__ATOMIC_RELEASE, "agent");
            asm volatile("s_waitcnt vmcnt(0)" ::: "memory");
            const unsigned og = xb_add(&bar[XB_TOP], 1u);
            const unsigned tg = og / nx;
            if (og + 1u == (tg + 1u) * nx) xb_add(&bar[XB_TOPGEN], 1u);
            else XB_SPIN(xb_ld(&bar[XB_TOPGEN]) == tg, bar);
            __builtin_amdgcn_fence(__ATOMIC_ACQUIRE, "agent");
            xb_add(&bar[XB_XGEN(b.x)], 1u);
            asm volatile("s_waitcnt vmcnt(0)" ::: "memory");
        } else {
            XB_SPIN(xb_ld(&bar[XB_XGEN(b.x)]) == gen, bar);
            __builtin_amdgcn_fence(__ATOMIC_ACQUIRE, "agent");
            asm volatile("s_waitcnt vmcnt(0)" ::: "memory");
        }
    }
    __syncthreads();
}

__global__ void __launch_bounds__(512, 2) fwd_kernel(Params P) {
    extern __shared__ __attribute__((aligned(16))) unsigned char lds_raw[];
    LAS unsigned char* lds = (LAS unsigned char*)lds_raw;
    cg::grid_group grid = cg::this_grid();
    const int tid = threadIdx.x, lane = tid & 63, wave = __builtin_amdgcn_readfirstlane(tid >> 6);
    const int G = gridDim.x, c = blockIdx.x;
    const int gw = c * 8 + wave, NGW = G * 8, gtid = c * 512 + tid, gthreads = G * 512;
    unsigned char* ws = P.ws;
    float* OUT = P.out;
    float* MOD = (float*)(ws + OFF_MOD);
    bf16_t* WFI = (bf16_t*)(ws + OFF_WFI); bf16_t* WFO = (bf16_t*)(ws + OFF_WFO); bf16_t* WABI = (bf16_t*)(ws + OFF_WABI);
    bf16_t* WUQ = (bf16_t*)(ws + OFF_WUQ); bf16_t* WUKV = (bf16_t*)(ws + OFF_WUKV); bf16_t* WABO = (bf16_t*)(ws + OFF_WABO);
    bf16_t* WCI = (bf16_t*)(ws + OFF_WCI); bf16_t* WCO = (bf16_t*)(ws + OFF_WCO);
    bf16_t* H = (bf16_t*)(ws + OFF_H); bf16_t* BIG = (bf16_t*)(ws + OFF_BIG); bf16_t* BQ = (bf16_t*)(ws + OFF_BQ);
    bf16_t* KV = (bf16_t*)(ws + OFF_KV); bf16_t* LAT = (bf16_t*)(ws + OFF_LAT); bf16_t* KR = (bf16_t*)(ws + OFF_KR);
    bf16_t* KAS = (bf16_t*)(ws + OFF_KAS); bf16_t* VAS = (bf16_t*)(ws + OFF_VAS); bf16_t* KCS = (bf16_t*)(ws + OFF_KCS); bf16_t* VCS = (bf16_t*)(ws + OFF_VCS);
    const float* xp = P.in[0]; const float* xs = P.in[1];
    if (tid == 0) { ((LAS unsigned*)(lds + 131072))[0] = 0u; ((LAS unsigned*)(lds + 131072))[1] = 0u; }
    __syncthreads();
    const XcdBarrier xb = xcd_barrier_post((unsigned*)(ws + OFF_BAR), (volatile LAS unsigned*)(lds + 131072));
    if (ws == nullptr) grid.sync();
    float* RGS = (float*)(ws + OFF_RGS); float* GS = (float*)(ws + OFF_GS); bf16_t* SHB = (bf16_t*)(ws + OFF_SHB); float* BW = (float*)(ws + OFF_BW); float* SSQ = (float*)(ws + OFF_SSQ);
    float* BWAB = BW + 4 * 24 * 5632; float* BWC = BWAB + 24 * 2304;
    bf16_t* OAB = (bf16_t*)(P.out + O_CKP);
    bf16_t* OC = KV;

    {
        LAS float* scr = (LAS float*)(lds + wave * 8448);
        constexpr int I_FI = 16 * 176, I_FO = 44 * 32, I_ABI = 16 * 72, I_UQ = 6 * 24, I_UKV = 4 * 32, I_SQ = 16 * 32, I_CI = 16 * 96;
        constexpr int NITEMS0 = 2 * I_FI + 2 * I_FO + I_ABI + I_UQ + I_UKV + I_SQ;
        for (int it = gw; it < NITEMS0; it += NGW) {
            int r = it;
            if (r < 2 * I_FI) { const int mi = r / I_FI; transpose_item(P.in[13] + (size_t)mi * 1024 * 5632, 1024, 5632, 5632, WFI + (size_t)mi * 5632 * 1024, 1, scr, r % I_FI, lane); continue; } r -= 2 * I_FI;
            if (r < 2 * I_FO) { const int mi = r / I_FO; transpose_item(P.in[14] + (size_t)mi * 2816 * 1024, 2816, 1024, 1024, WFO + (size_t)mi * 1024 * 2816, 0, scr, r % I_FO, lane); continue; } r -= 2 * I_FO;
            if (r < I_ABI) { transpose_item(P.in[15], 1024, 2240, 2304, WABI, 0, scr, r, lane); continue; } r -= I_ABI;
            if (r < I_UQ) { transpose_item(P.in[19], 384, 768, 768, WUQ, 0, scr, r, lane); continue; } r -= I_UQ;
            if (r < I_UKV) { transpose_item(P.in[21], 256, 1024, 1024, WUKV, 0, scr, r, lane); continue; } r -= I_UKV;
            transpose_item(P.in[22], 1024, 1024, 1024, WABO, 0, scr, r, lane);
        }
        conv_rows(P.in[2], KAS, 8, 1024, 512, LKSP, 0, gtid, gthreads);
        conv_rows(P.in[3], VAS, 8, 1024, 512, LKSP, 0, gtid, gthreads);
        conv_rows(P.in[4], LAT + (size_t)NP * 256, 8, 1024, 256, LKSP, 0, gtid, gthreads);
        conv_rows(P.in[5], KR + (size_t)NP * 64, 8, 1024, 64, LKSP, 0, gtid, gthreads);
        conv_rows(P.in[6], KCS, 8, 512, 1024, LCSP, 0, gtid, gthreads);
        conv_rows(P.in[7], VCS, 8, 512, 1024, LCSP, 0, gtid, gthreads);
        zero_rows(KAS, 8, 48, 512, LKSP, LKS, gtid, gthreads);
        zero_rows(VAS, 8, 48, 512, LKSP, LKS, gtid, gthreads);
        zero_rows(LAT + (size_t)NP * 256, 8, 48, 256, LKSP, LKS, gtid, gthreads);
        zero_rows(KR + (size_t)NP * 64, 8, 48, 64, LKSP, LKS, gtid, gthreads);
        zero_rows(KCS, 8, 48, 1024, LCSP, LCS, gtid, gthreads);
        zero_rows(VCS, 8, 48, 1024, LCSP, LCS, gtid, gthreads);
        for (int i = gtid; i < 6 * 33024; i += gthreads) SSQ[33024 + i] = 0.f;
        __syncthreads();
        LAS float* sc = (LAS float*)lds;
        for (int un = c; un < 288; un += G) {
            __syncthreads();
            for (int i = tid; i < 24 * 1024; i += 512) { const int b = i >> 10, k = i & 1023; const float v = b < 16 ? P.in[8][b * 1024 + k] : P.in[9][(b - 16) * 1024 + k];
                sc[k * 24 + b] = v / (1.0f + __expf(-v)); }
            __syncthreads();
            const int l = un / 144, n0 = (un % 144) * 64, col = n0 + lane;
            const float* Wp = P.in[10] + (size_t)l * 1024 * 9216 + col;
            float acc[24];
#pragma unroll
            for (int b = 0; b < 24; ++b) acc[b] = 0.f;
#pragma unroll 16
            for (int k = wave * 128; k < wave * 128 + 128; ++k) { const float wv = Wp[(size_t)k * 9216];
#pragma unroll
                for (int b4 = 0; b4 < 6; ++b4) { const f32x4 s4 = *(const LAS f32x4*)(sc + k * 24 + b4 * 4); acc[b4 * 4 + 0] += s4[0] * wv; acc[b4 * 4 + 1] += s4[1] * wv; acc[b4 * 4 + 2] += s4[2] * wv; acc[b4 * 4 + 3] += s4[3] * wv; } }
            __syncthreads();
            LAS float* red = (LAS float*)lds;
#pragma unroll
            for (int b = 0; b < 24; ++b) red[(wave * 24 + b) * 64 + lane] = acc[b];
            __syncthreads();
            for (int i = tid; i < 24 * 64; i += 512) { const int b = i >> 6, cl = i & 63; float s = P.in[11][l * 9216 + n0 + cl];
#pragma unroll
                for (int w8 = 0; w8 < 8; ++w8) s += red[(w8 * 24 + b) * 64 + cl];
                MOD[((size_t)l * 24 + b) * 9216 + n0 + cl] = s;
                const int n = n0 + cl, slot = n >> 10; if (slot == 0 || slot == 3 || slot == 6) SHB[((size_t)(l * 3 + slot / 3) * 128 + b) * 1024 + (n & 1023)] = (bf16_t)(pk2(s, 0.f) & 0xffff); }
        }
    }
    xcd_barrier(xb);

    float* X = OUT;
    {
        const float* gsl = P.in[12]; const float* mdl = MOD + 1024;
        for (int row = gw; row < MR; row += NGW) {
            const float* xr = row < NP ? xp + (size_t)row * DM : xs + (size_t)(row - NP) * DM;
            const int b = row_batch(row); f32x4 v[4]; float ss = 0.f;
#pragma unroll
            for (int j = 0; j < 4; ++j) { v[j] = *(const f32x4*)(xr + 4 * lane + 256 * j); ss += v[j][0] * v[j][0] + v[j][1] * v[j][1] + v[j][2] * v[j][2] + v[j][3] * v[j][3]; }
            ss = wave_sum(ss); if (lane == 0) SSQ[row] = ss;
#pragma unroll
            for (int j = 0; j < 4; ++j) { const int col = 4 * lane + 256 * j; const f32x4 gg = *(const f32x4*)(gsl + col); const f32x4 scl = *(const f32x4*)(mdl + (size_t)b * 9216 + col);
                const f32x4 hv = v[j] * gg * (scl + 1.0f); u32x2 o; o.x = pk2(hv[0], hv[1]); o.y = pk2(hv[2], hv[3]); *(u32x2*)(H + (size_t)row * DM + col) = o; }
        }
        for (int i = gtid; i < 6 * 24 * 1024; i += gthreads) { const int col = i & 1023, b = (i >> 10) % 24, inst = i / (24 * 1024), l = inst / 3, sub = inst % 3;
            const float gsv_ = P.in[12][inst * 1024 + col] * (1.0f + MOD[((size_t)l * 24 + b) * 9216 + (3 * sub + 1) * 1024 + col]); GS[i] = gsv_; RGS[i] = fabsf(gsv_) > 1e-20f ? 1.0f / gsv_ : 0.0f; }
        for (int i = gtid; i < 24 * 1024; i += gthreads) GS[6 * 24 * 1024 + i] = P.in[26][i & 1023];
        for (int un = gw; un < 848; un += NGW) {
            int r = un;
            if (r < 704) { const int mi = r / 352, inst = mi == 0 ? 0 : 2; wave_bias(SHB + (size_t)inst * 128 * 1024, WFI + (size_t)mi * 5632 * 1024, 5632, BW + (size_t)mi * 24 * 5632, r % 352, lane); continue; } r -= 704;
            wave_bias(SHB + (size_t)1 * 128 * 1024, WABI, 2304, BWAB, r, lane);
        }
    }
    xcd_barrier(xb);

#define FFN_PHASES(L, S2, FROM_IN, SSQ_IN, BW_IN, SSQ_OUT, GS_OUT, RGS_PREV, HASAN) do { \
        { small_swiglu(lds, H + (size_t)NP * DM, WFI + (size_t)((L) * 2 + (S2)) * 5632 * 1024, BIG, SSQ_IN, BW_IN, G, c); \
          pg8::Gemm gg_{H, WFI + (size_t)((L) * 2 + (S2)) * 5632 * 1024, NP, 5632, 1024, 1024}; pg8::StaticOrder so_; so_.init(NP, 5632, G, c); \
          pg8::EpiSwiglu e_{BIG, SSQ_IN, BW_IN}; pg8::gemm_phase(lds, gg_, so_, e_); } \
        xcd_barrier(xb); \
        { small_resid(lds, BIG + (size_t)NP * DFF, 2816, WFO + (size_t)((L) * 2 + (S2)) * 1024 * 2816, (FROM_IN) ? xs : nullptr, X, MOD + (size_t)(L) * 24 * 9216 + (3 * (2 * (S2)) + 2) * 1024, 0.5f, SSQ_OUT, GS_OUT, RGS_PREV, H, HASAN, G, c); \
          pg8::Gemm gg_{BIG, WFO + (size_t)((L) * 2 + (S2)) * 1024 * 2816, NP, 1024, 2816, 2816}; pg8::StaticOrder so_; so_.init(NP, 1024, G, c); \
          pg8::EpiResid<HASAN, FROM_IN> e_{xp, X, MOD + (size_t)(L) * 24 * 9216 + (3 * (2 * (S2)) + 2) * 1024, 0.5f, SSQ_OUT, GS_OUT, RGS_PREV, H}; pg8::gemm_phase(lds, gg_, so_, e_); } \
        xcd_barrier(xb); } while (0)

    FFN_PHASES(0, 0, false, SSQ, (BW + 0 * 24 * 5632), SSQ + 1 * 33024, GS + 1 * 24 * 1024, RGS, true);
    {
        small_bf16(lds, H + (size_t)NP * DM, 1024, 1024, WABI, 2240, BIG, PROJ_LD, 1.0f, SSQ + 1 * 33024, BWAB, 2304, G, (c + 128) % G);
        pg8::Gemm gg_{H, WABI, NP, 2304, 1024, 1024}; pg8::StaticOrder so_; so_.init(NP, 2304, G, c);
        pg8::EpiBf16<true> e_{BIG, PROJ_LD, 1.0f, SSQ + 1 * 33024, BWAB, 2304}; pg8::gemm_phase(lds, gg_, so_, e_);
    }
    xcd_barrier(xb);
    {
        const float* qng = P.in[18]; const float* kvg = P.in[20];
        const int dsub = (lane & 3) * 8; const bool ishi = (lane & 4) != 0;
        for (int row = gw; row < MR; row += NGW) {
            bf16_t* pr = BIG + (size_t)row * PROJ_LD;
            const int pos = row_pos(row);
            float cs[8], sn[8];
#pragma unroll
            for (int i = 0; i < 8; ++i) { const float inv = __builtin_amdgcn_exp2f(-(float)(dsub + i) * (13.287712379549449f / 32.0f)); const float ang_ = (float)pos * inv; sn[i] = __sinf(ang_); cs[i] = __cosf(ang_); }
            { const u32x4 raw = *(const u32x4*)(pr + lane * 8); float x[8], y[8];
#pragma unroll
              for (int i = 0; i < 4; ++i) { x[2 * i] = bf2f(raw[i] & 0xffff); x[2 * i + 1] = bf2f(raw[i] >> 16); }
#pragma unroll
              for (int i = 0; i < 8; ++i) { const float o = __shfl_xor(x[i], 4); y[i] = (ishi ? (x[i] * cs[i] + o * sn[i]) : (x[i] * cs[i] - o * sn[i])) * (0.125f * LOG2E); }
              u32x4 wv; wv.x = pk2(y[0], y[1]); wv.y = pk2(y[2], y[3]); wv.z = pk2(y[4], y[5]); wv.w = pk2(y[6], y[7]); *(u32x4*)(pr + lane * 8) = wv; }
            { const u32x4 raw = *(const u32x4*)(pr + 512 + lane * 8); float x[8], y[8];
#pragma unroll
              for (int i = 0; i < 4; ++i) { x[2 * i] = bf2f(raw[i] & 0xffff); x[2 * i + 1] = bf2f(raw[i] >> 16); }
#pragma unroll
              for (int i = 0; i < 8; ++i) { const float o = __shfl_xor(x[i], 4); y[i] = ishi ? (x[i] * cs[i] + o * sn[i]) : (x[i] * cs[i] - o * sn[i]); }
              float* fo = OUT + O_AK + (size_t)row * 512 + lane * 8; __builtin_nontemporal_store((f32x4){y[0], y[1], y[2], y[3]}, (f32x4*)fo); __builtin_nontemporal_store((f32x4){y[4], y[5], y[6], y[7]}, (f32x4*)(fo + 4));
              u32x4 wv; wv.x = pk2(y[0], y[1]); wv.y = pk2(y[2], y[3]); wv.z = pk2(y[4], y[5]); wv.w = pk2(y[6], y[7]);
              if (row < NP) *(u32x4*)(pr + 512 + lane * 8) = wv;
              else { const int bs = (row - NP) >> 4, t = (row - NP) & 15; *(u32x4*)(KAS + ((size_t)bs * LKSP + 1024 + t) * 512 + lane * 8) = wv; } }
            { const u32x4 raw = *(const u32x4*)(pr + 1024 + lane * 8); float x[8];
#pragma unroll
              for (int i = 0; i < 4; ++i) { x[2 * i] = bf2f(raw[i] & 0xffff); x[2 * i + 1] = bf2f(raw[i] >> 16); }
              float* fo = OUT + O_AV + (size_t)row * 512 + lane * 8; __builtin_nontemporal_store((f32x4){x[0], x[1], x[2], x[3]}, (f32x4*)fo); __builtin_nontemporal_store((f32x4){x[4], x[5], x[6], x[7]}, (f32x4*)(fo + 4));
              if (row >= NP) { const int bs = (row - NP) >> 4, t = (row - NP) & 15; *(u32x4*)(VAS + ((size_t)bs * LKSP + 1024 + t) * 512 + lane * 8) = raw; } }
            { float x[8]; u32x4 raw = (u32x4){0u, 0u, 0u, 0u}; if (lane < 48) raw = *(const u32x4*)(pr + 1536 + lane * 8);
              float ss = 0.f;
#pragma unroll
              for (int i = 0; i < 4; ++i) { x[2 * i] = bf2f(raw[i] & 0xffff); x[2 * i + 1] = bf2f(raw[i] >> 16); ss += x[2 * i] * x[2 * i] + x[2 * i + 1] * x[2 * i + 1]; }
              const float rstd = 1.0f / sqrtf(wave_sum(ss) * (1.0f / 384.0f) + EPS);
              if (lane < 48) { const f32x4 g0 = *(const f32x4*)(qng + lane * 8), g1 = *(const f32x4*)(qng + lane * 8 + 4);
                  u32x4 wv; wv.x = pk2(x[0] * rstd * g0[0], x[1] * rstd * g0[1]); wv.y = pk2(x[2] * rstd * g0[2], x[3] * rstd * g0[3]);
                  wv.z = pk2(x[4] * rstd * g1[0], x[5] * rstd * g1[1]); wv.w = pk2(x[6] * rstd * g1[2], x[7] * rstd * g1[3]); *(u32x4*)(pr + 1536 + lane * 8) = wv; } }
            { float x[8]; u32x4 raw = (u32x4){0u, 0u, 0u, 0u}; if (lane < 32) raw = *(const u32x4*)(pr + 1920 + lane * 8);
              float ss = 0.f;
#pragma unroll
              for (int i = 0; i < 4; ++i) { x[2 * i] = bf2f(raw[i] & 0xffff); x[2 * i + 1] = bf2f(raw[i] >> 16); ss += x[2 * i] * x[2 * i] + x[2 * i + 1] * x[2 * i + 1]; }
              const float rstd = 1.0f / sqrtf(wave_sum(ss) * (1.0f / 256.0f) + EPS);
              if (lane < 32) { const f32x4 g0 = *(const f32x4*)(kvg + lane * 8), g1 = *(const f32x4*)(kvg + lane * 8 + 4);
                  float y[8];
#pragma unroll
                  for (int i = 0; i < 4; ++i) { y[i] = x[i] * rstd * g0[i]; y[4 + i] = x[4 + i] * rstd * g1[i]; }
                  float* fo = OUT + O_LAT + (size_t)row * 256 + lane * 8; __builtin_nontemporal_store((f32x4){y[0], y[1], y[2], y[3]}, (f32x4*)fo); __builtin_nontemporal_store((f32x4){y[4], y[5], y[6], y[7]}, (f32x4*)(fo + 4));
                  const size_t lr = row < NP ? (size_t)row : (size_t)NP + (size_t)((row - NP) >> 4) * LKSP + 1024 + ((row - NP) & 15);
                  u32x4 wv; wv.x = pk2(y[0], y[1]); wv.y = pk2(y[2], y[3]); wv.z = pk2(y[4], y[5]); wv.w = pk2(y[6], y[7]); *(u32x4*)(LAT + lr * 256 + lane * 8) = wv; } }
            { float x[8], y[8]; u32x4 raw = (u32x4){0u, 0u, 0u, 0u}; if (lane < 8) raw = *(const u32x4*)(pr + 2176 + lane * 8);
#pragma unroll
              for (int i = 0; i < 4; ++i) { x[2 * i] = bf2f(raw[i] & 0xffff); x[2 * i + 1] = bf2f(raw[i] >> 16); }
#pragma unroll
              for (int i = 0; i < 8; ++i) { const float o = __shfl_xor(x[i], 4); y[i] = ishi ? (x[i] * cs[i] + o * sn[i]) : (x[i] * cs[i] - o * sn[i]); }
              if (lane < 8) { float* fo = OUT + O_KR + (size_t)row * 64 + lane * 8; __builtin_nontemporal_store((f32x4){y[0], y[1], y[2], y[3]}, (f32x4*)fo); __builtin_nontemporal_store((f32x4){y[4], y[5], y[6], y[7]}, (f32x4*)(fo + 4));
                  const size_t lr = row < NP ? (size_t)row : (size_t)NP + (size_t)((row - NP) >> 4) * LKSP + 1024 + ((row - NP) & 15);
                  u32x4 wv; wv.x = pk2(y[0], y[1]); wv.y = pk2(y[2], y[3]); wv.z = pk2(y[4], y[5]); wv.w = pk2(y[6], y[7]); *(u32x4*)(KR + lr * 64 + lane * 8) = wv; } }
        }
    }
    xcd_barrier(xb);
    {
        small_bf16(lds, BIG + (size_t)NP * PROJ_LD + 1536, PROJ_LD, 384, WUQ, 768, BQ, 768, 0.07216878364870322f * LOG2E, nullptr, nullptr, 0, G, (c + 128) % G);
        { pg8::Gemm gg_{BIG + 1536, WUQ, NP, 768, 384, PROJ_LD}; pg8::StaticOrder so_; so_.init(NP, 768, G, c);
          pg8::EpiBf16<false> e_{BQ, 768, 0.07216878364870322f * LOG2E, nullptr, nullptr, 0}; pg8::gemm_phase(lds, gg_, so_, e_); }
        { pg8::Gemm gg_{LAT, WUKV, MKV, 1024, 256, 256}; pg8::StaticOrder so_; so_.init(MKV, 1024, G, (c + 128) % G);
          pg8::EpiBf16<false> e_{KV, 1024, 1.0f, nullptr, nullptr, 0}; pg8::gemm_phase(lds, gg_, so_, e_); }
    }
    xcd_barrier(xb);
    {
        const float* al = P.in[16];
        const float lam = __expf(wave_sum(al[lane] * al[64 + lane])) - __expf(wave_sum(al[128 + lane] * al[192 + lane])) + LAM_INIT;
        const int xcd = c & 7, jx = c >> 3, bh = xcd * 8 + (jx >> 2), b = bh >> 2, h = bh & 3, a0 = (2 * jx) & 7, pb = jx & 3;
        const size_t rb = (size_t)b * 2048;
        for (int rr = 0; rr < 7; ++rr) {
            if (rr == 6 && c >= 64) continue;
            AU u; u.k2 = nullptr; u.ldk2 = 0; u.h = 0; u.kpos0 = 0; u.nqw = 8; u.kt0 = 0; u.lk = 1 << 30;
            int kind;
            if (rr == 1 || rr == 4) {
                const int p8 = rr == 1 ? pb : 7 - pb; const size_t r0 = rb + 256 * p8; kind = 1;
                u.kt1 = 4 * p8 + 4; u.qpos0 = 256 * p8;
                u.q = BQ + r0 * 768 + h * 192; u.ldq = 768; u.k1 = KV + rb * 1024 + h * 256; u.ldk1 = 1024; u.k2 = KR + rb * 64; u.ldk2 = 64; u.v = KV + rb * 1024 + h * 256 + 128; u.ldv = 1024; u.o = OAB + r0 * DM + 512 + h * 128;
            } else if (rr < 6) {
                const int qi = rr == 0 ? a0 : (rr == 2 ? 15 - a0 : (rr == 3 ? a0 + 1 : 14 - a0)); const size_t r0 = rb + 128 * qi; kind = 0;
                u.kt1 = 2 * qi + 2; u.qpos0 = 128 * qi;
                u.q = BIG + r0 * PROJ_LD + h * 128; u.ldq = PROJ_LD; u.k1 = BIG + rb * PROJ_LD + 512 + h * 128; u.ldk1 = PROJ_LD; u.v = BIG + rb * PROJ_LD + 1024 + h * 128; u.ldv = PROJ_LD; u.o = OAB + r0 * DM + h * 128;
            } else {
                const int si = c, sbh = si & 31, sb = sbh >> 2, sh = sbh & 3; kind = (si >> 5) ? 2 : 0;
                const size_t r0 = (size_t)NP + 16 * sb;
                u.nqw = 1; u.kt1 = 17; u.lk = LKS; u.qpos0 = 1024;
                if (kind == 0) { u.q = BIG + r0 * PROJ_LD + sh * 128; u.ldq = PROJ_LD; u.k1 = KAS + (size_t)sb * LKSP * 512 + sh * 128; u.ldk1 = 512; u.v = VAS + (size_t)sb * LKSP * 512 + sh * 128; u.ldv = 512; u.o = OAB + r0 * DM + sh * 128; }
                else { const size_t kr0 = (size_t)NP + (size_t)sb * LKSP; u.q = BQ + r0 * 768 + sh * 192; u.ldq = 768; u.k1 = KV + kr0 * 1024 + sh * 256; u.ldk1 = 1024; u.k2 = KR + kr0 * 64; u.ldk2 = 64; u.v = KV + kr0 * 1024 + sh * 256 + 128; u.ldv = 1024; u.o = OAB + r0 * DM + 512 + sh * 128; }
            }
            if (kind == 0) attn_unit<0, 1>(lds, u, lam, P.in[17], nullptr);
            else if (kind == 1) attn_unit<1, 2>(lds, u, lam, nullptr, nullptr);
            else attn_unit<1, 1>(lds, u, lam, nullptr, nullptr);
        }
        if (c >= 64) {
            LAS float* scr = (LAS float*)(lds + wave * 8448);
            constexpr int I_FI = 16 * 176, I_FO = 44 * 32, I_SQ = 16 * 32, I_CI = 16 * 96;
            constexpr int NITEMS1 = 2 * I_FI + 2 * I_FO + I_CI + I_SQ;
            for (int it = (c - 64) * 8 + wave; it < NITEMS1; it += 192 * 8) {
                int r = it;
                if (r < 2 * I_FI) { const int mi = 2 + r / I_FI; transpose_item(P.in[13] + (size_t)mi * 1024 * 5632, 1024, 5632, 5632, WFI + (size_t)mi * 5632 * 1024, 1, scr, r % I_FI, lane); continue; } r -= 2 * I_FI;
                if (r < 2 * I_FO) { const int mi = 2 + r / I_FO; transpose_item(P.in[14] + (size_t)mi * 2816 * 1024, 2816, 1024, 1024, WFO + (size_t)mi * 1024 * 2816, 0, scr, r % I_FO, lane); continue; } r -= 2 * I_FO;
                if (r < I_CI) { transpose_item(P.in[23], 1024, 3072, 3072, WCI, 0, scr, r, lane); continue; } r -= I_CI;
                transpose_item(P.in[25], 1024, 1024, 1024, WCO, 0, scr, r, lane);
            }
        }
    }
    xcd_barrier(xb);
    {
        for (int un = gw; un < 896; un += NGW) {
            int r = un;
            if (r < 704) { const int mi = 2 + r / 352, inst = mi == 2 ? 3 : 5; wave_bias(SHB + (size_t)inst * 128 * 1024, WFI + (size_t)mi * 5632 * 1024, 5632, BW + (size_t)mi * 24 * 5632, r % 352, lane); continue; } r -= 704;
            wave_bias(SHB + (size_t)4 * 128 * 1024, WCI, 3072, BWC, r, lane);
        }
        small_resid(lds, OAB + (size_t)NP * DM, 1024, WABO, nullptr, X, MOD + (size_t)5 * 1024, 1.0f, SSQ + 2 * 33024, GS + 2 * 24 * 1024, RGS + 1 * 24 * 1024, H, true, G, c);
        pg8::Gemm gg_{OAB, WABO, NP, 1024, 1024, 1024}; pg8::StaticOrder so_; so_.init(NP, 1024, G, c);
        pg8::EpiResid<true, false> e_{xp, X, MOD + (size_t)5 * 1024, 1.0f, SSQ + 2 * 33024, GS + 2 * 24 * 1024, RGS + 1 * 24 * 1024, H}; pg8::gemm_phase(lds, gg_, so_, e_);
    }
    xcd_barrier(xb);
    FFN_PHASES(0, 1, false, SSQ + 2 * 33024, (BW + 1 * 24 * 5632), SSQ + 3 * 33024, GS + 3 * 24 * 1024, RGS + 2 * 24 * 1024, true);

    FFN_PHASES(1, 0, false, SSQ + 3 * 33024, (BW + 2 * 24 * 5632), SSQ + 4 * 33024, GS + 4 * 24 * 1024, RGS + 3 * 24 * 1024, true);
    {
        small_cqkv(lds, H + (size_t)NP * DM, WCI, BIG, 0.125f * LOG2E, OUT, KCS, VCS, SSQ + 4 * 33024, BWC, G, c);
        pg8::Gemm gg_{H, WCI, NP, 3072, 1024, 1024}; pg8::StaticOrder so_; so_.init(NP, 3072, G, c);
        pg8::EpiCqkv e_{BIG, 0.125f * LOG2E, OUT, SSQ + 4 * 33024, BWC}; pg8::gemm_phase(lds, gg_, so_, e_);
    }
    xcd_barrier(xb);
    {
        LAS float* biasT = (LAS float*)(lds + 65536);
        for (int i = tid; i < 16 * 257; i += 512) biasT[i] = P.in[24][i] * LOG2E;
        __syncthreads();
        const int xcd = c & 7, jx = c >> 3;
        for (int rr = 0; rr < 9; ++rr) {
            if (rr == 8 && c >= 128) continue;
            AU u; u.k2 = nullptr; u.ldk2 = 0;
            if (rr < 8) {
                const int bh = xcd * 32 + 4 * rr + (jx & 3), q8 = ((jx >> 2) + rr) & 7, b = bh >> 4, h = bh & 15;
                const size_t r0 = (size_t)b * 2048 + 256 * q8, rb = (size_t)b * 2048;
                u.q = BIG + r0 * 3072 + h * 64; u.ldq = 3072; u.k1 = BIG + rb * 3072 + 1024 + h * 64; u.ldk1 = 3072; u.v = BIG + rb * 3072 + 2048 + h * 64; u.ldv = 3072; u.o = OC + r0 * DM + h * 64;
                u.nqw = 8; u.kt0 = 4 * q8 - 8 < 0 ? 0 : 4 * q8 - 8; u.kt1 = 4 * q8 + 4; u.lk = 1 << 30; u.qpos0 = 256 * q8; u.kpos0 = 0; u.h = h;
                attn_unit<2, 2>(lds, u, 0.f, nullptr, biasT);
            } else {
                const int bh = c, b = bh >> 4, h = bh & 15;
                const size_t r0 = (size_t)NP + 16 * b;
                u.q = BIG + r0 * 3072 + h * 64; u.ldq = 3072; u.k1 = KCS + (size_t)b * LCSP * 1024 + h * 64; u.ldk1 = 1024; u.v = VCS + (size_t)b * LCSP * 1024 + h * 64; u.ldv = 1024; u.o = OC + r0 * DM + h * 64;
                u.nqw = 1; u.kt0 = 0; u.kt1 = 9; u.lk = LCS; u.qpos0 = 1024; u.kpos0 = 512; u.h = h;
                attn_unit<2, 1>(lds, u, 0.f, nullptr, biasT);
            }
        }
    }
    xcd_barrier(xb);
    {
        small_resid(lds, OC + (size_t)NP * DM, 1024, WCO, nullptr, X, MOD + (size_t)24 * 9216 + (size_t)5 * 1024, 1.0f, SSQ + 5 * 33024, GS + 5 * 24 * 1024, RGS + 4 * 24 * 1024, H, true, G, c);
        pg8::Gemm gg_{OC, WCO, NP, 1024, 1024, 1024}; pg8::StaticOrder so_; so_.init(NP, 1024, G, c);
        pg8::EpiResid<true, false> e_{xp, X, MOD + (size_t)24 * 9216 + (size_t)5 * 1024, 1.0f, SSQ + 5 * 33024, GS + 5 * 24 * 1024, RGS + 4 * 24 * 1024, H}; pg8::gemm_phase(lds, gg_, so_, e_);
    }
    xcd_barrier(xb);
    FFN_PHASES(1, 1, false, SSQ + 5 * 33024, (BW + 3 * 24 * 5632), SSQ + 6 * 33024, GS + 6 * 24 * 1024, RGS + 5 * 24 * 1024, true);
    {
        for (int row = gw; row < MR; row += NGW) {
            float* xr = X + (size_t)row * DM; const bf16_t* hr = H + (size_t)row * DM; const float rstd = 1.0f / sqrtf(SSQ[6 * 33024 + row] * (1.0f / 1024.0f) + EPS);
#pragma unroll
            for (int j = 0; j < 4; ++j) { const u32x2 r_ = *(const u32x2*)(hr + 4 * lane + 256 * j);
                __builtin_nontemporal_store((f32x4){bf2f(r_.x & 0xffff), bf2f(r_.x >> 16), bf2f(r_.y & 0xffff), bf2f(r_.y >> 16)} * rstd, (f32x4*)(xr + 4 * lane + 256 * j)); }
        }
        { const long total = (long)8 * 496 * 256;
          for (long i = gtid; i < total; i += gthreads) { const int cc = (int)(i & 255); const long br = i >> 8; const int j = (int)(br % 496), b = (int)(br / 496);
              const size_t so = ((size_t)b * 512 + j + 16) * 1024 + cc * 4, dof = ((size_t)b * 512 + j) * 1024 + cc * 4;
              *(f32x4*)(OUT + O_CKS + dof) = *(const f32x4*)(P.in[6] + so); *(f32x4*)(OUT + O_CVS + dof) = *(const f32x4*)(P.in[7] + so); } }
    }
}

extern "C" void kernel_launch(void* const* d_in, const int* in_sizes, int n_in, void* d_out, int out_size, void* d_ws, size_t ws_size, hipStream_t stream) {
    static int grid = 0;
    if (grid == 0) {
        if (n_in != 27 || (size_t)out_size != O_END || ws_size < WS_END) { fprintf(stderr, "kernel_launch: unexpected sizes n_in %d out %d ws %zu (need %zu)\n", n_in, out_size, ws_size, (size_t)WS_END); grid = -1; return; }
        int dev = 0, cus = 0, per_cu = 0;
        hipGetDevice(&dev);
        hipDeviceGetAttribute(&cus, hipDeviceAttributeMultiprocessorCount, dev);
        hipFuncSetAttribute((const void*)fwd_kernel, hipFuncAttributeMaxDynamicSharedMemorySize, LDS_BYTES);
        hipOccupancyMaxActiveBlocksPerMultiprocessor(&per_cu, (const void*)fwd_kernel, 512, LDS_BYTES);
        if (per_cu < 1) { fprintf(stderr, "kernel_launch: occupancy query says %d blocks/CU\n", per_cu); per_cu = 1; }
        (void)hipGetLastError();
        grid = cus;
    }
    if (grid < 0) return;
    Params p{};
    for (int i = 0; i < 27; ++i) p.in[i] = (const float*)d_in[i];
    p.out = (float*)d_out; p.ws = (unsigned char*)d_ws;
    hipMemsetAsync((char*)d_ws + OFF_BAR, 0, (size_t)XCD_BAR_WORDS * 4, stream);
    void* args[] = {&p};
    hipError_t e = hipLaunchCooperativeKernel((const void*)fwd_kernel, dim3(grid), dim3(512), args, LDS_BYTES, stream);
    if (e != hipSuccess) fprintf(stderr, "cooperative launch failed: %s (grid %d)\n", hipGetErrorString(e), grid);
}
```
